# Optimizing an MI355X kernel written in HIP

```python
import jax, jax.numpy as jnp
from jax import lax
import numpy as np

D_MODEL = 2048
BATCH = 4
SEQ = 4096
DEPTH = 2

N_MIXERS = 2
FOX_HEADS = 16
FOX_HEAD_DIM = D_MODEL // FOX_HEADS
RET_HEADS = 8
RET_QK_DIM = D_MODEL // RET_HEADS
RET_V_DIM = 2 * RET_QK_DIM
D_FF = 4 * D_MODEL
Q_BLOCK = 128
RET_CHUNK = 128
RMS_EPS = 1e-6
ROPE_BASE = 10000.0
N_FOX = (DEPTH + 1) // 2
N_RET = DEPTH // 2

kernel_name = "fox_retnet_hybrid_trunk"


def rmsnorm(x, g):
    x32 = x.astype(jnp.float32)
    y = x32 * lax.rsqrt(jnp.mean(jnp.square(x32), axis=-1, keepdims=True) + RMS_EPS)
    return (y * g.astype(jnp.float32)).astype(x.dtype)


def fox_mixer(h, wq, wk, wv, wf, bf, wo):
    B, S, _ = h.shape
    H, dh = FOX_HEADS, FOX_HEAD_DIM

    def heads(w):
        return (h @ w).reshape(B, S, H, dh).transpose(0, 2, 1, 3).astype(jnp.float32)

    q = heads(wq) * (dh ** -0.5)
    k = heads(wk)
    v = heads(wv)
    log_f = jax.nn.log_sigmoid((h @ wf + bf).astype(jnp.float32))
    c = jnp.cumsum(log_f, axis=1).transpose(0, 2, 1)

    nb = S // Q_BLOCK
    q_blocks = q.reshape(B, H, nb, Q_BLOCK, dh).transpose(2, 0, 1, 3, 4)
    c_blocks = c.reshape(B, H, nb, Q_BLOCK).transpose(2, 0, 1, 3)
    k_pos = jnp.arange(S)

    def one_block(args):
        qi, ci, bi = args
        q_pos = bi * Q_BLOCK + jnp.arange(Q_BLOCK)
        logits = jnp.einsum('bhqd,bhkd->bhqk', qi, k) + ci[..., None] - c[:, :, None, :]
        logits = jnp.where(k_pos[None, :] <= q_pos[:, None], logits, -jnp.inf)
        p = jax.nn.softmax(logits, axis=-1)
        return jnp.einsum('bhqk,bhkd->bhqd', p, v)

    o = lax.map(one_block, (q_blocks, c_blocks, jnp.arange(nb)))
    o = o.transpose(1, 0, 3, 2, 4).reshape(B, S, H * dh)
    return o.astype(h.dtype) @ wo


def rotary(x, pos):
    half = x.shape[-1] // 2
    inv = ROPE_BASE ** (-jnp.arange(half, dtype=jnp.float32) / half)
    ang = pos[:, None] * inv[None, :]
    cos, sin = jnp.cos(ang), jnp.sin(ang)
    x1, x2 = x[..., :half], x[..., half:]
    return jnp.concatenate([x1 * cos - x2 * sin, x1 * sin + x2 * cos], axis=-1)


def retention_mixer(h, wq, wk, wv, wg, gn, wo):
    B, S, _ = h.shape
    H, dk, dv, C = RET_HEADS, RET_QK_DIM, RET_V_DIM, RET_CHUNK
    pos = jnp.arange(S, dtype=jnp.float32)
    q = (h @ wq).reshape(B, S, H, dk).transpose(0, 2, 1, 3).astype(jnp.float32)
    k = (h @ wk).reshape(B, S, H, dk).transpose(0, 2, 1, 3).astype(jnp.float32)
    v = (h @ wv).reshape(B, S, H, dv).transpose(0, 2, 1, 3).astype(jnp.float32)
    q = rotary(q, pos)
    k = rotary(k, pos) * (dk ** -0.5)

    log_gamma = jnp.log1p(-jnp.exp2(-5.0 - jnp.arange(H, dtype=jnp.float32)))
    idx = jnp.arange(C, dtype=jnp.float32)
    diff = idx[:, None] - idx[None, :]
    decay_in = jnp.where(diff >= 0,
                         jnp.exp(log_gamma[:, None, None] * jnp.maximum(diff, 0.0)), 0.0)
    q_decay = jnp.exp(log_gamma[:, None] * (idx + 1.0))[:, :, None]
    k_decay = jnp.exp(log_gamma[:, None] * (C - 1.0 - idx))[:, :, None]
    chunk_decay = jnp.exp(log_gamma * C)[:, None, None]

    nc = S // C
    qc = q.reshape(B, H, nc, C, dk).transpose(2, 0, 1, 3, 4)
    kc = k.reshape(B, H, nc, C, dk).transpose(2, 0, 1, 3, 4)
    vc = v.reshape(B, H, nc, C, dv).transpose(2, 0, 1, 3, 4)

    def step(state, xs):
        qi, ki, vi = xs
        inner = jnp.einsum('bhid,bhjd->bhij', qi, ki) * decay_in
        o = (jnp.einsum('bhij,bhje->bhie', inner, vi)
             + jnp.einsum('bhid,bhde->bhie', qi * q_decay, state))
        state = chunk_decay * state + jnp.einsum('bhjd,bhje->bhde', ki * k_decay, vi)
        return state, o

    state0 = jnp.zeros((B, H, dk, dv), jnp.float32)
    _, o = lax.scan(step, state0, (qc, kc, vc))
    o = o.transpose(1, 0, 3, 2, 4).reshape(B, S, H, dv)
    o = o * lax.rsqrt(jnp.mean(jnp.square(o), axis=-1, keepdims=True) + RMS_EPS)
    o = o.reshape(B, S, H * dv) * gn.astype(jnp.float32)
    gate = jax.nn.silu((h @ wg).astype(jnp.float32))
    return (gate * o).astype(h.dtype) @ wo


def sqrelu_mlp(h, w_up, w_down):
    return jnp.square(jax.nn.relu(h @ w_up)) @ w_down


def setup_inputs(seed: int = 0) -> dict:
    key = jax.random.key(seed)
    ks = jax.random.split(key, 24)
    D = D_MODEL

    def w(k, shape, fan_in):
        return jax.random.normal(k, shape, jnp.float32) * (fan_in ** -0.5)

    def gain(k, shape):
        return 1.0 + 0.05 * jax.random.normal(k, shape, jnp.float32)

    fd = FOX_HEADS * FOX_HEAD_DIM
    rk = RET_HEADS * RET_QK_DIM
    rv = RET_HEADS * RET_V_DIM
    return {
        "x": jax.random.normal(ks[0], (BATCH, SEQ, D), jnp.float32),
        "fox_norm": gain(ks[1], (N_FOX, D)),
        "fox_wq": w(ks[2], (N_FOX, D, fd), D),
        "fox_wk": w(ks[3], (N_FOX, D, fd), D),
        "fox_wv": w(ks[4], (N_FOX, D, fd), D),
        "fox_wf": w(ks[5], (N_FOX, D, FOX_HEADS), D),
        "fox_bf": jax.random.uniform(ks[6], (N_FOX, FOX_HEADS), jnp.float32, 1.0, 5.0),
        "fox_wo": w(ks[7], (N_FOX, fd, D), fd),
        "ret_norm": gain(ks[8], (N_RET, D)),
        "ret_wq": w(ks[9], (N_RET, D, rk), D),
        "ret_wk": w(ks[10], (N_RET, D, rk), D),
        "ret_wv": w(ks[11], (N_RET, D, rv), D),
        "ret_wg": w(ks[12], (N_RET, D, rv), D),
        "ret_gn": gain(ks[13], (N_RET, rv)),
        "ret_wo": w(ks[14], (N_RET, rv, D), rv),
        "mlp_norm": gain(ks[15], (DEPTH, D)),
        "mlp_up": w(ks[16], (DEPTH, D, D_FF), D),
        "mlp_down": w(ks[17], (DEPTH, D_FF, D), D_FF),
        "final_norm": gain(ks[18], (D,)),
    }


def reference(x, fox_norm, fox_wq, fox_wk, fox_wv, fox_wf, fox_bf, fox_wo,
              ret_norm, ret_wq, ret_wk, ret_wv, ret_wg, ret_gn, ret_wo,
              mlp_norm, mlp_up, mlp_down, final_norm):
    h = x
    for layer in range(DEPTH):
        j = layer // N_MIXERS
        if layer % N_MIXERS == 0:
            h = h + fox_mixer(rmsnorm(h, fox_norm[j]), fox_wq[j], fox_wk[j], fox_wv[j],
                              fox_wf[j], fox_bf[j], fox_wo[j])
        else:
            h = h + retention_mixer(rmsnorm(h, ret_norm[j]), ret_wq[j], ret_wk[j], ret_wv[j],
                                    ret_wg[j], ret_gn[j], ret_wo[j])
        h = h + sqrelu_mlp(rmsnorm(h, mlp_norm[layer]), mlp_up[layer], mlp_down[layer])
    return rmsnorm(h, final_norm)
```

```cpp
#include <hip/hip_runtime.h>
#include <hip/hip_cooperative_groups.h>
#include <cstdio>
#include <cstdint>
namespace cg = cooperative_groups;

#ifndef MK_PER_PHASE
#define MK_PER_PHASE 0
#endif

#define LAS __attribute__((address_space(3)))
typedef unsigned short bf16_t;
typedef short bf16x8 __attribute__((ext_vector_type(8)));
typedef short s16x4 __attribute__((ext_vector_type(4)));
typedef float f32x4 __attribute__((ext_vector_type(4)));
typedef float f32x16 __attribute__((ext_vector_type(16)));
typedef unsigned u32x4 __attribute__((ext_vector_type(4)));
typedef unsigned u32x2 __attribute__((ext_vector_type(2)));

constexpr int MTOK = 16384, DM = 2048, SEQ = 4096, DFF = 8192;
constexpr float RMS_EPS = 1e-6f;
constexpr float LOG2E = 1.4426950408889634f;
constexpr int NTHREADS = 512, NWAVES = 8;
constexpr int LDS_BYTES = 144 * 1024 + 256;

constexpr size_t MiB = 1u << 20;
constexpr size_t WS_RS = 0, WS_BAR = 128 * 1024, WS_RAT = 256 * 1024, WS_COS = 1 * MiB, WS_SIN = 3 * MiB, WS_LF = 5 * MiB, WS_C2 = 6 * MiB, WS_SS = 7 * MiB, WS_PS = 7 * MiB;
constexpr size_t WS_RWQKG = 12 * MiB;
constexpr size_t WS_RWV = 44 * MiB;
constexpr size_t WS_RWO = 60 * MiB;
constexpr size_t WS_UP1 = 76 * MiB, WS_DN1 = 108 * MiB;
constexpr size_t WS_FQKF = 140 * MiB;
constexpr size_t WS_FWV = 157 * MiB, WS_FWO = 165 * MiB, WS_UP0 = 173 * MiB, WS_DN0 = 205 * MiB;
constexpr size_t WS_XN = 237 * MiB;
constexpr size_t WS_FQ = 301 * MiB, WS_FK = 365 * MiB, WS_FVT = 429 * MiB, WS_FO = 493 * MiB;
constexpr size_t WS_U = 301 * MiB;
constexpr size_t WS_G = 301 * MiB;
constexpr size_t WS_VDT = 140 * MiB;
constexpr size_t WS_QR = 204 * MiB;
constexpr size_t WS_KR = 429 * MiB;
constexpr size_t WS_KT = 461 * MiB;
constexpr size_t WS_ST = 493 * MiB;
constexpr size_t WS_END = 576 * MiB;
static_assert(WS_ST + 68 * MiB <= WS_END, "ws map");

struct Params {
    const float* x; const float* fox_norm; const float* fox_wq; const float* fox_wk; const float* fox_wv; const float* fox_wf; const float* fox_bf; const float* fox_wo;
    const float* ret_norm; const float* ret_wq; const float* ret_wk; const float* ret_wv; const float* ret_wg; const float* ret_gn; const float* ret_wo;
    const float* mlp_norm; const float* mlp_up; const float* mlp_down; const float* final_norm;
    float* out; unsigned char* ws; int ph_lo, ph_hi;
};

typedef float cv_f32x2 __attribute__((ext_vector_type(2))); typedef __bf16 cv_bf16x2 __attribute__((ext_vector_type(2)));
__device__ __forceinline__ unsigned cvt_pk_bf16(float lo, float hi) { cv_f32x2 v = {lo, hi}; cv_bf16x2 b = __builtin_convertvector(v, cv_bf16x2); return __builtin_bit_cast(unsigned, b); }
__device__ __forceinline__ unsigned f2bf(float f) { unsigned u = __builtin_bit_cast(unsigned, f); return (u + 0x7fffu + ((u >> 16) & 1u)) >> 16; }
__device__ __forceinline__ unsigned pk2(float lo, float hi) { return f2bf(lo) | (f2bf(hi) << 16); }
__device__ __forceinline__ float bf2f(unsigned short b) { return __builtin_bit_cast(float, (unsigned)b << 16); }
__device__ __forceinline__ void st_bf16x8(bf16_t* p, f32x4 v0, f32x4 v1) {
    u32x4 w; w.x = cvt_pk_bf16(v0[0], v0[1]); w.y = cvt_pk_bf16(v0[2], v0[3]); w.z = cvt_pk_bf16(v1[0], v1[1]); w.w = cvt_pk_bf16(v1[2], v1[3]);
    *(u32x4*)p = w;
}
__device__ __forceinline__ float wave_sum(float v) {
#pragma unroll
    for (int o = 1; o < 64; o <<= 1) v += __shfl_xor(v, o);
    return v;
}
__device__ __forceinline__ float fexp2(float x) { return __builtin_amdgcn_exp2f(x); }
__device__ __forceinline__ int remap8(int L, int nwg) {
    const int q = nwg / 8, r = nwg % 8, xcd = L % 8, off = L / 8;
    return (xcd < r ? xcd * (q + 1) : r * (q + 1) + (xcd - r) * q) + off;
}
__device__ __forceinline__ void tile_of(int L, int nM, int nN, int& pm, int& pn) {
    const int wgid = remap8(L, nM * nN);
    const int nig = 8 * nN, gid = wgid / nig, fm = gid * 8, gsz = (nM - fm) < 8 ? (nM - fm) : 8;
    pm = fm + ((wgid % nig) % gsz); pn = (wgid % nig) / gsz;
}

namespace pg {
constexpr int BM = 256, BK = 64, HALF = 128, HTB = HALF * BK * 2, STAGE_BYTES = 8 * HTB;
__device__ __forceinline__ int lds_byte(int r, int c) { const int st = (r >> 4) * 2 + (c >> 5), rr = r & 15, cc = c & 31, ob = rr * 64 + cc * 2; return st * 1024 + (ob ^ (((ob >> 9) & 1) << 5)); }
__device__ __forceinline__ void stage_rc(int b, int& R, int& C) { const int st = b / 1024, sb = b % 1024, swz = sb ^ (((sb >> 9) & 1) << 5); R = (st >> 1) * 16 + swz / 64; C = (st & 1) * 32 + (swz % 64) / 2; }
__device__ __forceinline__ int perm32(int rho) { const int n = rho >> 4, i = rho & 15; return 8 * (i >> 2) + 4 * n + (i & 3); }

struct Unit { const char* a; const char* b; const char* a2; const char* b2; int kind, pm, pn, x; };
struct Cfg { int lda, ldb, nt, nt1; };

template <class Epi, class Sched>
__device__ __forceinline__ void gemm_phase(LAS unsigned char* lds, const int tid, const Cfg g, const Sched& S, const Epi& E) {
    const int wid = __builtin_amdgcn_readfirstlane(tid >> 6), lane = tid & 63, wr = wid >> 2, wc = wid & 3, fr = lane & 15, fq = lane >> 4;
    const int nt = g.nt, nt1 = g.nt1;
    unsigned voffA[2], voffB[2];
#pragma unroll
    for (int i = 0; i < 2; ++i) { int R, C; stage_rc(tid * 16 + i * 8192, R, C); const int Rb = (R & ~31) + perm32(R & 31);
        voffA[i] = (unsigned)(R * g.lda + C) * 2u; voffB[i] = (unsigned)(Rb * g.ldb + C) * 2u; }
    const size_t kstep = (size_t)(BK * 2);
    const size_t hstepA = (size_t)HALF * g.lda * 2, hstepB = (size_t)HALF * g.ldb * 2;
    const unsigned ldsw = (unsigned)wid * 1024u;
    const int aoff = lds_byte(wr * 64 + fr, fq * 8), boff = lds_byte(wc * 32 + fr, fq * 8);
#define PG8_SA(b, h) (((b) * 2 + (h)) * HTB)
#define PG8_SB(b, h) ((4 + (b) * 2 + (h)) * HTB)
#define PG8_STAGE(bufoff, gbase, voff) do { _Pragma("unroll") for (int _i = 0; _i < 2; ++_i) \
        __builtin_amdgcn_global_load_lds((const unsigned*)((const char*)(gbase) + (voff)[_i]), (LAS unsigned*)(lds + (bufoff) + ldsw + _i * 8192), 16, 0, 0); } while (0)
#define PG8_LDA(dst, b, h) do { _Pragma("unroll") for (int m = 0; m < 4; ++m) _Pragma("unroll") for (int k = 0; k < 2; ++k) dst[m][k] = *(const LAS bf16x8*)(lds + PG8_SA(b, h) + aoff + m * 2048 + k * 1024); } while (0)
#define PG8_LDB(dst, b, h) do { _Pragma("unroll") for (int n = 0; n < 2; ++n) _Pragma("unroll") for (int k = 0; k < 2; ++k) dst[n][k] = *(const LAS bf16x8*)(lds + PG8_SB(b, h) + boff + n * 2048 + k * 1024); } while (0)
#define PG8_MMA(ai, bj, At, Bt) do { __builtin_amdgcn_s_setprio(1); _Pragma("unroll") for (int m = 0; m < 4; ++m) _Pragma("unroll") for (int n = 0; n < 2; ++n) _Pragma("unroll") for (int k = 0; k < 2; ++k) \
        acc[ai][bj][m][n] = __builtin_amdgcn_mfma_f32_16x16x32_bf16(Bt[n][k], At[m][k], acc[ai][bj][m][n], 0, 0, 0); __builtin_amdgcn_s_setprio(0); } while (0)
#define PG8_WAIT_V(n) asm volatile("s_waitcnt vmcnt(" #n ")" ::: "memory")
#define PG8_WAIT_L(n) asm volatile("s_waitcnt lgkmcnt(" #n ")" ::: "memory")
#define PG8_BAR __builtin_amdgcn_s_barrier()
#define PG8_SCHED __builtin_amdgcn_sched_barrier(0)
#define PG8_KA(u, kt) ((kt) < nt1 ? (u).a + (size_t)(kt) * kstep : (u).a2 + (size_t)((kt) - nt1) * kstep)
#define PG8_KB(u, kt) ((kt) < nt1 ? (u).b + (size_t)(kt) * kstep : (u).b2 + (size_t)((kt) - nt1) * kstep)
    Unit cur, nxt; int ui = 0;
    if (!S.next(0, cur)) return;
    f32x4 acc[2][2][4][2];
#pragma unroll
    for (int a = 0; a < 2; ++a)
#pragma unroll
        for (int b = 0; b < 2; ++b)
#pragma unroll
            for (int m = 0; m < 4; ++m)
#pragma unroll
                for (int n = 0; n < 2; ++n) acc[a][b][m][n] = (f32x4){0.f, 0.f, 0.f, 0.f};
    bf16x8 At[4][2], B0[2][2], B1[2][2];
    if constexpr (Epi::HOOK) { const f32x4 hv = E.hook_load(cur, tid); E.hook_store(lds + STAGE_BYTES, hv, tid); }
    {
        const char* cA = cur.a; const char* cB = cur.b;
        PG8_STAGE(PG8_SB(0, 0), cB, voffB); PG8_STAGE(PG8_SB(0, 1), cB + hstepB, voffB); PG8_STAGE(PG8_SA(0, 0), cA, voffA); PG8_STAGE(PG8_SA(0, 1), cA + hstepA, voffA);
        if (wr == 1) PG8_BAR;
        PG8_WAIT_V(2); PG8_BAR;
        PG8_STAGE(PG8_SB(1, 0), cB + kstep, voffB); PG8_STAGE(PG8_SA(1, 0), cA + kstep, voffA); PG8_STAGE(PG8_SB(1, 1), cB + hstepB + kstep, voffB);
        PG8_WAIT_V(6); PG8_BAR;
    }
    for (;;) {
        const bool has_next = S.next(ui + 1, nxt);
        if (!has_next) nxt = cur;
#pragma nounroll
        for (int t = 0; t < nt; t += 2) {
            const bool last = (t == nt - 2);
            const char* a1 = PG8_KA(cur, t + 1);
            const char* a2 = last ? nxt.a : PG8_KA(cur, t + 2); const char* b2 = last ? nxt.b : PG8_KB(cur, t + 2);
            const char* a3 = last ? nxt.a + kstep : PG8_KA(cur, t + 3); const char* b3 = last ? nxt.b + kstep : PG8_KB(cur, t + 3);
            PG8_LDB(B0, 0, 0); PG8_LDB(B1, 0, 1); PG8_SCHED; PG8_LDA(At, 0, 0); PG8_STAGE(PG8_SA(1, 1), a1 + hstepA, voffA);
            PG8_WAIT_V(8); PG8_WAIT_L(0); PG8_BAR; PG8_MMA(0, 0, At, B0); PG8_MMA(0, 1, At, B1); PG8_BAR; PG8_SCHED;
            PG8_LDA(At, 0, 1); PG8_STAGE(PG8_SB(0, 0), b2, voffB); PG8_STAGE(PG8_SB(0, 1), b2 + hstepB, voffB); PG8_STAGE(PG8_SA(0, 0), a2, voffA);
            PG8_WAIT_V(8); PG8_WAIT_L(0); PG8_BAR; PG8_MMA(1, 0, At, B0); PG8_MMA(1, 1, At, B1); PG8_BAR; PG8_SCHED;
            PG8_LDB(B0, 1, 0); PG8_LDB(B1, 1, 1); PG8_SCHED; PG8_LDA(At, 1, 0); PG8_STAGE(PG8_SA(0, 1), a2 + hstepA, voffA);
            PG8_WAIT_V(8); PG8_WAIT_L(0); PG8_BAR; PG8_MMA(0, 0, At, B0); PG8_MMA(0, 1, At, B1); PG8_BAR; PG8_SCHED;
            PG8_LDA(At, 1, 1); PG8_STAGE(PG8_SB(1, 0), b3, voffB); PG8_STAGE(PG8_SB(1, 1), b3 + hstepB, voffB); PG8_STAGE(PG8_SA(1, 0), a3, voffA);
            PG8_WAIT_V(8); PG8_WAIT_L(0); PG8_BAR; PG8_MMA(1, 0, At, B0); PG8_MMA(1, 1, At, B1); PG8_BAR; PG8_SCHED;
            if constexpr (Epi::HOOK) { if (((t + 2) & 7) == 0) { int tl = tid; asm volatile("" : "+v"(tl)); E.hook(acc, lds + STAGE_BYTES + (ui & 1) * 8192, ((t + 2) >> 3) - 1, wr, tl & 15); PG8_SCHED; } }
        }
        if (wr == 0) PG8_BAR;
        if constexpr (Epi::HOOK) {
            int tl = tid; asm volatile("" : "+v"(tl));
            const f32x4 hv = E.hook_load(nxt, tl);
            E(acc, cur, wr, wc, tl & 15, (tl & 63) >> 4);
            E.hook_store(lds + STAGE_BYTES + ((ui + 1) & 1) * 8192, hv, tl);
        } else
        { int tl = tid; asm volatile("" : "+v"(tl)); E(acc, cur, wr, wc, tl & 15, (tl & 63) >> 4); }
        if (!has_next) break;
#pragma unroll
        for (int a = 0; a < 2; ++a)
#pragma unroll
            for (int b = 0; b < 2; ++b)
#pragma unroll
                for (int m = 0; m < 4; ++m)
#pragma unroll
                    for (int n = 0; n < 2; ++n) acc[a][b][m][n] = (f32x4){0.f, 0.f, 0.f, 0.f};
        cur = nxt; ++ui;
        if (wr == 1) PG8_BAR;
    }
    PG8_WAIT_V(0);
    PG8_BAR;
#undef PG8_SA
#undef PG8_SB
#undef PG8_STAGE
#undef PG8_LDA
#undef PG8_LDB
#undef PG8_MMA
#undef PG8_WAIT_V
#undef PG8_WAIT_L
#undef PG8_BAR
#undef PG8_SCHED
#undef PG8_KA
#undef PG8_KB
}
}
using pg::Unit;

#define EPI_ROWS(...) _Pragma("unroll") for (int ai = 0; ai < 2; ++ai) _Pragma("unroll") for (int m = 0; m < 4; ++m) { const int row = ai * 128 + wr * 64 + m * 16 + fr + zz; __VA_ARGS__; asm volatile("" ::: "memory"); }
typedef f32x4 Acc[2][2][4][2];

struct SchedPlain {
    const char* A; const char* B; int nM, nN; size_t astep, bstep; int G, c;
    __device__ __forceinline__ bool next(int i, Unit& u) const {
        const long L = (long)i * G + c; if (L >= (long)nM * nN) return false;
        int pm, pn; tile_of((int)L, nM, nN, pm, pn);
        u.a = A + (size_t)pm * astep; u.b = B + (size_t)pn * bstep; u.a2 = u.a; u.b2 = u.b; u.kind = 0; u.pm = pm; u.pn = pn; u.x = 0; return true;
    }
};
template <bool F32BASE> struct EpiResT {
    static constexpr bool HOOK = false;
    const float* basef; bf16_t* HB; float* PS; int ps_on;
    __device__ __forceinline__ void operator()(const Acc& acc, const Unit& u, int wr, int wc, int fr, int fq) const {
        int zz = 0; asm volatile("" : "+v"(zz));
        EPI_ROWS(
            float ss = 0.f;
            _Pragma("unroll") for (int bj = 0; bj < 2; ++bj) {
                const size_t p = (size_t)(u.pm * 256 + row) * DM + u.pn * 256 + bj * 128 + wc * 32 + fq * 8;
                f32x4 b0, b1;
                if (F32BASE) { b0 = *(const f32x4*)(basef + p); b1 = *(const f32x4*)(basef + p + 4); }
                else { const u32x4 hv = *(const u32x4*)(HB + p);
                    b0[0] = __builtin_bit_cast(float, hv.x << 16); b0[1] = __builtin_bit_cast(float, hv.x & 0xffff0000u); b0[2] = __builtin_bit_cast(float, hv.y << 16); b0[3] = __builtin_bit_cast(float, hv.y & 0xffff0000u);
                    b1[0] = __builtin_bit_cast(float, hv.z << 16); b1[1] = __builtin_bit_cast(float, hv.z & 0xffff0000u); b1[2] = __builtin_bit_cast(float, hv.w << 16); b1[3] = __builtin_bit_cast(float, hv.w & 0xffff0000u); }
                const f32x4 v0 = b0 + acc[ai][bj][m][0], v1 = b1 + acc[ai][bj][m][1];
                st_bf16x8(HB + p, v0, v1);
                ss += (v0[0] * v0[0] + v0[1] * v0[1]) + (v0[2] * v0[2] + v0[3] * v0[3]) + (v1[0] * v1[0] + v1[1] * v1[1]) + (v1[2] * v1[2] + v1[3] * v1[3]); }
            if (ps_on) { ss += __shfl_xor(ss, 16); ss += __shfl_xor(ss, 32); if (fq == 0) PS[(size_t)(u.pm * 256 + row) * 32 + u.pn * 4 + wc] = ss; })
    }
};
typedef EpiResT<false> EpiRes;
struct EpiResHook : EpiRes {
    static constexpr bool HOOK = true;
    const float* RAT;
    __device__ __forceinline__ f32x4 hook_load(const Unit& u, int tid) const { return *(const f32x4*)(RAT + (size_t)u.pm * 2048 + tid * 4); }
    __device__ __forceinline__ void hook_store(LAS unsigned char* lx, f32x4 v, int tid) const { *(LAS f32x4*)(lx + tid * 16) = v; }
    __device__ __forceinline__ void hook(Acc& acc, LAS const unsigned char* lx, int hk, int wr, int fr) const {
#pragma unroll
        for (int ai = 0; ai < 2; ++ai)
#pragma unroll
            for (int m = 0; m < 4; ++m) {
                const float rt = *(LAS const float*)(lx + ((ai * 128 + wr * 64 + m * 16 + fr) * 8 + hk) * 4);
#pragma unroll
                for (int bj = 0; bj < 2; ++bj)
#pragma unroll
                    for (int n = 0; n < 2; ++n) acc[ai][bj][m][n] *= rt;
            }
    }
};
struct EpiUp {
    static constexpr bool HOOK = false;
    bf16_t* U; const float* PS;
    __device__ __forceinline__ void operator()(const Acc& acc, const Unit& u, int wr, int wc, int fr, int fq) const {
        int zz = 0; asm volatile("" : "+v"(zz));
        EPI_ROWS(
            float rs;
            { const f32x4 pa = *(const f32x4*)(PS + (size_t)(u.pm * 256 + row) * 32 + fq * 8), pb = *(const f32x4*)(PS + (size_t)(u.pm * 256 + row) * 32 + fq * 8 + 4);
              float tot = ((pa.x + pa.y) + (pa.z + pa.w)) + ((pb.x + pb.y) + (pb.z + pb.w));
              tot += __shfl_xor(tot, 16); tot += __shfl_xor(tot, 32);
              rs = 1.f / sqrtf(tot * (1.f / DM) + RMS_EPS); }
            _Pragma("unroll") for (int bj = 0; bj < 2; ++bj) {
                f32x4 v0 = acc[ai][bj][m][0] * rs, v1 = acc[ai][bj][m][1] * rs;
                _Pragma("unroll") for (int e = 0; e < 4; ++e) { const float a = fmaxf(v0[e], 0.f), b = fmaxf(v1[e], 0.f); v0[e] = a * a; v1[e] = b * b; }
                st_bf16x8(U + (size_t)(u.pm * 256 + row) * DFF + u.pn * 256 + bj * 128 + wc * 32 + fq * 8, v0, v1); })
    }
};

struct SchedF1 {
    const char* XN; const char* Wqkf; const char* Wv; int G, c;
    __device__ __forceinline__ bool next(int i, Unit& u) const {
        long L = (long)i * G + c; int pm, pn;
        if (L < 64 * 16) { tile_of((int)L, 64, 16, pm, pn); u.a = XN + (size_t)pm * 256 * DM * 2; u.b = Wqkf + (size_t)pn * 256 * DM * 2; u.kind = pn < 8 ? 0 : 1; }
        else { L -= 64 * 16; if (L >= 8 * 64) return false; tile_of((int)L, 8, 64, pm, pn); u.a = Wv + (size_t)pm * 256 * DM * 2; u.b = XN + (size_t)pn * 256 * DM * 2; u.kind = 3; }
        u.a2 = u.a; u.b2 = u.b; u.pm = pm; u.pn = pn; u.x = 0; return true;
    }
};
struct EpiF1 {
    static constexpr bool HOOK = false;
    bf16_t* Q; bf16_t* K; bf16_t* VT; float* LF; const float* bfv; float qscale; const float* RS;
    __device__ __forceinline__ void operator()(const Acc& acc, const Unit& u, int wr, int wc, int fr, int fq) const {
        int zz = 0; asm volatile("" : "+v"(zz));
        bf16_t* base; size_t ld; float sc = 1.f;
        if (u.kind == 0) { base = Q + (size_t)u.pm * 256 * DM + u.pn * 256; ld = DM; sc = qscale; }
        else if (u.kind == 1) { base = K + (size_t)u.pm * 256 * DM + (u.pn - 8) * 256; ld = DM; }
        else { base = VT + (size_t)u.pm * 256 * MTOK + u.pn * 256; ld = MTOK; }
        if (u.kind == 3) {
            f32x4 cs[2][2];
            _Pragma("unroll") for (int bj = 0; bj < 2; ++bj) _Pragma("unroll") for (int nn = 0; nn < 2; ++nn) cs[bj][nn] = *(const f32x4*)(RS + u.pn * 256 + bj * 128 + wc * 32 + fq * 8 + nn * 4 + zz);
            EPI_ROWS(
                _Pragma("unroll") for (int bj = 0; bj < 2; ++bj)
                    st_bf16x8(base + (size_t)row * ld + bj * 128 + wc * 32 + fq * 8, acc[ai][bj][m][0] * cs[bj][0], acc[ai][bj][m][1] * cs[bj][1]);)
            return;
        }
        EPI_ROWS(
            const float rs = RS[u.pm * 256 + row] * sc;
            _Pragma("unroll") for (int bj = 0; bj < 2; ++bj)
                st_bf16x8(base + (size_t)row * ld + bj * 128 + wc * 32 + fq * 8, acc[ai][bj][m][0] * rs, acc[ai][bj][m][1] * rs);)
    }
};

__device__ __forceinline__ float ret_lg2(int h) { return log2f(1.f - exp2f(-5.f - (float)h)); }
struct SchedR1 {
    const char* XNh; const char* Wqkg; const char* Wv; int G, c;
    __device__ __forceinline__ bool next(int i, Unit& u) const {
        long L = (long)i * G + c; int pm, pn;
        if (L < 32 * 32) { tile_of((int)L, 32, 32, pm, pn); u.a = XNh + (size_t)pm * 256 * DM * 2; u.b = Wqkg + (size_t)pn * 256 * DM * 2; u.kind = pn < 8 ? 0 : (pn < 16 ? 1 : 2); }
        else { L -= 32 * 32; if (L >= 16 * 32) return false; tile_of((int)L, 16, 32, pm, pn); u.a = Wv + (size_t)pm * 256 * DM * 2; u.b = XNh + (size_t)pn * 256 * DM * 2; u.kind = 3; }
        u.a2 = u.a; u.b2 = u.b; u.pm = pm; u.pn = pn; u.x = 0; return true;
    }
};
struct EpiR1 {
    static constexpr bool HOOK = false;
    bf16_t* QR; bf16_t* KR; bf16_t* KT; bf16_t* Gt; bf16_t* VDT; const float* cosT; const float* sinT; int hb; const float* RS;
    __device__ __forceinline__ void operator()(const Acc& acc, const Unit& u, int wr, int wc, int fr, int fq) const {
        int zz = 0; asm volatile("" : "+v"(zz));
        if (u.kind <= 1) {
            const int h = u.pn & 7, bl = u.pm >> 4, n = u.pm & 15, bhl = bl * 8 + h;
            bf16_t* dst = (u.kind == 0 ? QR : KR) + ((size_t)bhl * SEQ + n * 256) * 256;
            bf16_t* dstT = KT + (size_t)(bhl * 16 + n) * 65536;
            const float sc = u.kind == 0 ? 1.f : 0.0625f;
            const int j0 = wc * 32 + fq * 8;
            EPI_ROWS(
                const int s = n * 256 + row;
                const float rs = RS[hb * 8192 + u.pm * 256 + row] * sc;
                _Pragma("unroll") for (int nn = 0; nn < 2; ++nn) {
                    const f32x4 cs = *(const f32x4*)(cosT + (size_t)s * 128 + j0 + nn * 4), sn = *(const f32x4*)(sinT + (size_t)s * 128 + j0 + nn * 4);
                    const f32x4 x1 = acc[ai][0][m][nn], x2 = acc[ai][1][m][nn];
                    const f32x4 o1 = (x1 * cs - x2 * sn) * rs, o2 = (x1 * sn + x2 * cs) * rs;
                    u32x2 w1, w2; w1.x = cvt_pk_bf16(o1[0], o1[1]); w1.y = cvt_pk_bf16(o1[2], o1[3]); w2.x = cvt_pk_bf16(o2[0], o2[1]); w2.y = cvt_pk_bf16(o2[2], o2[3]);
                    *(u32x2*)(dst + (size_t)row * 256 + j0 + nn * 4) = w1; *(u32x2*)(dst + (size_t)row * 256 + 128 + j0 + nn * 4) = w2;
                    if (u.kind == 1) {
                        _Pragma("unroll") for (int e = 0; e < 4; ++e) {
                            const unsigned a = e < 2 ? w1.x : w1.y, b = e < 2 ? w2.x : w2.y;
                            dstT[(size_t)(j0 + nn * 4 + e) * 256 + row] = (bf16_t)((e & 1) ? (a >> 16) : (a & 0xffffu));
                            dstT[(size_t)(128 + j0 + nn * 4 + e) * 256 + row] = (bf16_t)((e & 1) ? (b >> 16) : (b & 0xffffu)); }
                    } })
        } else if (u.kind == 2) {
            bf16_t* base = Gt + ((size_t)hb * 8192 + u.pm * 256) * 4096 + (u.pn - 16) * 256;
            EPI_ROWS(
                const float rs = RS[hb * 8192 + u.pm * 256 + row];
                _Pragma("unroll") for (int bj = 0; bj < 2; ++bj) {
                    f32x4 v0 = acc[ai][bj][m][0] * rs, v1 = acc[ai][bj][m][1] * rs;
                    _Pragma("unroll") for (int e = 0; e < 4; ++e) { v0[e] = v0[e] * __builtin_amdgcn_rcpf(1.f + fexp2(-v0[e] * LOG2E)); v1[e] = v1[e] * __builtin_amdgcn_rcpf(1.f + fexp2(-v1[e] * LOG2E)); }
                    st_bf16x8(base + (size_t)row * 4096 + bj * 128 + wc * 32 + fq * 8, v0, v1); })
        } else {
            const int h = u.pm >> 1, et = u.pm & 1, bl = u.pn >> 4, n = u.pn & 15, bhl = bl * 8 + h;
            const float lg = ret_lg2(h);
            bf16_t* base = VDT + ((size_t)(bhl * 16 + n) * 512 + et * 256) * 256;
            f32x4 dk[2][2];
            _Pragma("unroll") for (int bj = 0; bj < 2; ++bj) _Pragma("unroll") for (int nn = 0; nn < 2; ++nn) _Pragma("unroll") for (int e = 0; e < 4; ++e)
                dk[bj][nn][e] = fexp2((float)(255 - (bj * 128 + wc * 32 + fq * 8 + nn * 4 + e)) * lg) * RS[hb * 8192 + u.pn * 256 + bj * 128 + wc * 32 + fq * 8 + nn * 4 + e + zz];
            EPI_ROWS(
                _Pragma("unroll") for (int bj = 0; bj < 2; ++bj)
                    st_bf16x8(base + (size_t)row * 256 + bj * 128 + wc * 32 + fq * 8, acc[ai][bj][m][0] * dk[bj][0], acc[ai][bj][m][1] * dk[bj][1]);)
        }
    }
};

struct SchedR2 {
    const char* QR; const char* KR; const char* KT; const char* VDT; int G, c;
    __device__ __forceinline__ bool next(int i, Unit& u) const {
        long L = (long)i * G + c;
        if (L < 256) { const int id = remap8((int)L, 256); u.pm = id >> 4; u.pn = id & 15; u.kind = 0; u.x = 0;
            u.a = QR + ((size_t)u.pm * SEQ + u.pn * 256) * 512; u.b = KR + ((size_t)u.pm * SEQ + u.pn * 256) * 512; }
        else { L -= 256; if (L >= 480) return false; const int id = remap8((int)L, 480); const int bhl = id / 30, rem = id % 30; u.pm = bhl; u.pn = rem >> 1; u.x = rem & 1; u.kind = 1;
            u.a = VDT + ((size_t)(bhl * 16 + u.pn) * 512 + u.x * 256) * 512; u.b = KT + (size_t)(bhl * 16 + u.pn) * 131072; }
        u.a2 = u.a; u.b2 = u.b; return true;
    }
};
struct EpiR2 {
    static constexpr bool HOOK = false;
    bf16_t* KR; bf16_t* ST;
    __device__ __forceinline__ void operator()(const Acc& acc, const Unit& u, int wr, int wc, int fr, int fq) const {
        int zz = 0; asm volatile("" : "+v"(zz));
        if (u.kind == 0) {
            const float sc = fexp2(-256.f * ret_lg2(u.pm & 7));
            bf16_t* base = KR + ((size_t)u.pm * SEQ + u.pn * 256) * 256;
            EPI_ROWS(
                _Pragma("unroll") for (int bj = 0; bj < 2; ++bj) {
                    const int c0 = bj * 128 + wc * 32 + fq * 8; f32x4 v0, v1;
                    _Pragma("unroll") for (int e = 0; e < 4; ++e) { v0[e] = (c0 + e <= row) ? acc[ai][bj][m][0][e] * sc : 0.f; v1[e] = (c0 + 4 + e <= row) ? acc[ai][bj][m][1][e] * sc : 0.f; }
                    st_bf16x8(base + (size_t)row * 256 + c0, v0, v1); })
        } else {
            bf16_t* base = ST + ((size_t)(u.pm * 17 + u.pn + 1) * 512 + u.x * 256) * 256;
            EPI_ROWS(
                _Pragma("unroll") for (int bj = 0; bj < 2; ++bj)
                    st_bf16x8(base + (size_t)row * 256 + bj * 128 + wc * 32 + fq * 8, acc[ai][bj][m][0], acc[ai][bj][m][1]);)
        }
    }
};

struct SchedR4 {
    const char* P; const char* QR; const char* VDT; const char* ST; int G, c;
    __device__ __forceinline__ bool next(int i, Unit& u) const {
        const long L = (long)i * G + c; if (L >= 512) return false;
        const int id = remap8((int)L, 512); const int bhl = id >> 5, n = (id >> 1) & 15, et = id & 1;
        u.pm = bhl; u.pn = n; u.x = et; u.kind = 0;
        u.a = P + ((size_t)bhl * SEQ + n * 256) * 512; u.a2 = QR + ((size_t)bhl * SEQ + n * 256) * 512;
        u.b = VDT + ((size_t)(bhl * 16 + n) * 512 + et * 256) * 512; u.b2 = ST + ((size_t)(bhl * 17 + n) * 512 + et * 256) * 512;
        return true;
    }
};
struct EpiR4 {
    static constexpr bool HOOK = false;
    bf16_t* Gt; float* SS; const float* gn; int hb;
    __device__ __forceinline__ void operator()(const Acc& acc, const Unit& u, int wr, int wc, int fr, int fq) const {
        int zz = 0; asm volatile("" : "+v"(zz));
        const int h = u.pm & 7, bl = u.pm >> 3, et = u.x;
        const float lg = ret_lg2(h);
        const size_t tok0 = (size_t)hb * 8192 + bl * SEQ + u.pn * 256;
        const int cbase = h * 512 + et * 256;
        EPI_ROWS(
            const float qd = fexp2((float)(row + 1) * lg);
            float ss = 0.f;
            _Pragma("unroll") for (int bj = 0; bj < 2; ++bj) {
                const int c0 = cbase + bj * 128 + wc * 32 + fq * 8;
                bf16_t* gp = Gt + (tok0 + row) * 4096 + c0;
                const u32x4 gv = *(const u32x4*)gp;
                const f32x4 g0 = *(const f32x4*)(gn + c0), g1 = *(const f32x4*)(gn + c0 + 4);
                f32x4 v0 = acc[ai][bj][m][0] * qd, v1 = acc[ai][bj][m][1] * qd;
                ss += (v0[0] * v0[0] + v0[1] * v0[1]) + (v0[2] * v0[2] + v0[3] * v0[3]) + (v1[0] * v1[0] + v1[1] * v1[1]) + (v1[2] * v1[2] + v1[3] * v1[3]);
                f32x4 t0, t1;
                t0[0] = __builtin_bit_cast(float, gv.x << 16); t0[1] = __builtin_bit_cast(float, gv.x & 0xffff0000u); t0[2] = __builtin_bit_cast(float, gv.y << 16); t0[3] = __builtin_bit_cast(float, gv.y & 0xffff0000u);
                t1[0] = __builtin_bit_cast(float, gv.z << 16); t1[1] = __builtin_bit_cast(float, gv.z & 0xffff0000u); t1[2] = __builtin_bit_cast(float, gv.w << 16); t1[3] = __builtin_bit_cast(float, gv.w & 0xffff0000u);
                st_bf16x8(gp, v0 * g0 * t0, v1 * g1 * t1); }
            ss += __shfl_xor(ss, 16); ss += __shfl_xor(ss, 32);
            if (fq == 0) SS[((tok0 + row) * 8 + h) * 8 + et * 4 + wc] = ss;)
    }
};

constexpr int AT_KP = 272, AT_VP = 144, AT_KBUF = 64 * AT_KP, AT_VBUF = 128 * AT_VP, AT_VOFF = 2 * AT_KBUF, AT_COFF = AT_VOFF + 3 * AT_VBUF, AT_QOFF = AT_COFF + 512;
constexpr int AT_LDS_END = AT_QOFF + 8 * 5120;
__device__ __forceinline__ int crow(int r, int hi) { return (r & 3) + 8 * (r >> 2) + 4 * hi; }
constexpr float AT_THR = 8.f;
__device__ __forceinline__ float at_max3(float a, float b, float c) { float r; asm("v_max3_f32 %0, %1, %2, %3" : "=v"(r) : "v"(a), "v"(b), "v"(c)); return r; }
#define AT_MFMA(a, b, c) __builtin_amdgcn_mfma_f32_32x32x16_bf16((a), (b), (c), 0, 0, 0)
typedef float at_f32x2 __attribute__((ext_vector_type(2))); typedef __bf16 at_bf16x2 __attribute__((ext_vector_type(2)));
__device__ __forceinline__ unsigned at_cvt_pk(float lo, float hi) { at_f32x2 v = {lo, hi}; at_bf16x2 b = __builtin_convertvector(v, at_bf16x2); return __builtin_bit_cast(unsigned, b); }
#define AT_FRAG_LD(A0, A1, QF, Kb, Qb, ks) do { A0 = *(LAS const bf16x8*)((Kb) + (ks) * 32); A1 = *(LAS const bf16x8*)((Kb) + 32 * AT_KP + (ks) * 32); \
        if ((ks) >= 3) QF = *(LAS const bf16x8*)((Qb) + ((((ks) - 3) * 2 + hh) << 4)); } while (0)
#define AT_QSEL(QF, ks) (((ks) < 3) ? qreg[(ks) < 3 ? (ks) : 0] : (QF))
#define AT_SB() __builtin_amdgcn_sched_barrier(0)
#define AT_EXP_STEP(S0, S1, ks) do { S0[2 * (ks)] = fexp2(S0[2 * (ks)]); S0[2 * (ks) + 1] = fexp2(S0[2 * (ks) + 1]); S1[2 * (ks)] = fexp2(S1[2 * (ks)]); S1[2 * (ks) + 1] = fexp2(S1[2 * (ks) + 1]); \
        ls += (S0[2 * (ks)] + S0[2 * (ks) + 1]) + (S1[2 * (ks)] + S1[2 * (ks) + 1]); \
        pw[(ks) >> 2][(ks) & 3] = at_cvt_pk(S0[2 * (ks)], S0[2 * (ks) + 1]); pw[2 + ((ks) >> 2)][(ks) & 3] = at_cvt_pk(S1[2 * (ks)], S1[2 * (ks) + 1]); } while (0)
#define AT_BIAS_G(S0, S1, cbuf, g) do { LAS const float* cb_ = (LAS const float*)(lds + AT_COFF + (cbuf) * 256) + hh * 4; \
        const f32x4 c0 = *(LAS const f32x4*)(cb_ + 8 * (g)), c1 = *(LAS const f32x4*)(cb_ + 32 + 8 * (g)); \
        _Pragma("unroll") for (int e = 0; e < 4; ++e) { S0[4 * (g) + e] -= c0[e]; S1[4 * (g) + e] -= c1[e]; } } while (0)
#define AT_MASK_MAX(S0, S1, tt, jbb, MX) do { \
        if ((jbb) >= 0) { const int kv0 = 64 * (tt) + 4 * hh; \
            _Pragma("unroll") for (int i = 0; i < 16; ++i) { const int kv = kv0 + (i & 3) + 8 * (i >> 2); if (kv > q_row) S0[i] = -INFINITY; if (kv + 32 > q_row) S1[i] = -INFINITY; } } \
        float mx_ = at_max3(S0[0], S0[1], S1[0]), my_ = at_max3(S0[2], S0[3], S1[1]); mx_ = at_max3(mx_, S1[2], S1[3]); \
        _Pragma("unroll") for (int i = 4; i < 16; i += 4) { mx_ = at_max3(mx_, S0[i], S0[i + 1]); my_ = at_max3(my_, S0[i + 2], S0[i + 3]); mx_ = at_max3(mx_, S1[i], S1[i + 1]); my_ = at_max3(my_, S1[i + 2], S1[i + 3]); } \
        mx_ = fmaxf(mx_, my_); MX = fmaxf(mx_, __shfl_xor(mx_, 32)); } while (0)
#define AT_BIAS_MAX(S0, S1, cbuf, tt, jbb, MX) do { _Pragma("unroll") for (int g_ = 0; g_ < 4; ++g_) AT_BIAS_G(S0, S1, cbuf, g_); AT_MASK_MAX(S0, S1, tt, jbb, MX); } while (0)
__device__ __forceinline__ void attn_unit(LAS unsigned char* lds, const int tid_in, int bh, int qb, const bf16_t* __restrict__ Q, const bf16_t* __restrict__ K, const bf16_t* __restrict__ VT, const float* __restrict__ c2, bf16_t* __restrict__ O) {
    int tid = tid_in; asm volatile("" : "+v"(tid));
    const int lane = tid & 63, r = lane & 31, hh = lane >> 5;
    const int wid = __builtin_amdgcn_readfirstlane(tid >> 6);
    const int b = bh >> 4, h = bh & 15;
    const int q_row = qb * 256 + wid * 32 + r;
    LAS unsigned char* Qb = lds + AT_QOFF + wid * 5120 + r * 160;
    bf16x8 qreg[3];
    {
        const bf16_t* Qp = Q + ((size_t)(b * SEQ + q_row)) * DM + h * 128 + hh * 8;
#pragma unroll
        for (int ks = 0; ks < 3; ++ks) qreg[ks] = *(const bf16x8*)(Qp + ks * 16);
#pragma unroll
        for (int ks = 3; ks < 8; ++ks) *(LAS bf16x8*)(Qb + (((ks - 3) * 2 + hh) << 4)) = *(const bf16x8*)(Qp + ks * 16);
    }
    const float c2ref = c2[bh * SEQ + qb * 256];
    const int NT = (qb + 1) * 4;
    const int krow = tid >> 4, kch = tid & 15;
    const bf16_t* Ksrc = K + ((size_t)(b * SEQ + krow)) * DM + h * 128 + kch * 8;
    const int kdst = krow * AT_KP + kch * 16;
    const int vrow = tid >> 3, vch = tid & 7;
    const bf16_t* Vsrc = VT + ((size_t)(h * 128 + vrow)) * MTOK + b * SEQ + vch * 8;
    const int vdst = AT_VOFF + vrow * AT_VP + (vch >> 1) * 32 + (vch & 1) * 8;
    const float* csrc = c2 + bh * SEQ + (tid & 63);
    u32x4 kr[2], vr[2]; float cr = 0.f;
#define AT_LOAD(t) do { _Pragma("unroll") for (int i = 0; i < 2; ++i) { kr[i] = *(const u32x4*)(Ksrc + (size_t)(64 * (t) + 32 * i) * DM); vr[i] = *(const u32x4*)(Vsrc + 64 * (t) + (size_t)i * 64 * MTOK); } \
        if (tid < 64) cr = csrc[64 * (t)] - c2ref; } while (0)
#define AT_STORE(kb, vb) do { _Pragma("unroll") for (int i = 0; i < 2; ++i) { *(LAS u32x4*)(lds + (kb) * AT_KBUF + kdst + i * 32 * AT_KP) = kr[i]; \
        *(LAS u32x2*)(lds + (vb) * AT_VBUF + vdst + i * 64 * AT_VP) = (u32x2){vr[i].x, vr[i].y}; *(LAS u32x2*)(lds + (vb) * AT_VBUF + vdst + i * 64 * AT_VP + 16) = (u32x2){vr[i].z, vr[i].w}; } \
        if (tid < 64) *(LAS float*)(lds + AT_COFF + (kb) * 256 + tid * 4) = cr; } while (0)
    f32x16 o[4];
#pragma unroll
    for (int d = 0; d < 4; ++d)
#pragma unroll
        for (int i = 0; i < 16; ++i) o[d][i] = 0.f;
    float mref = 0.f, lrun = 0.f, mxc = 0.f;
    f32x16 sc0, sc1;
    AT_LOAD(0); AT_STORE(0, 0);
    AT_LOAD(1); AT_STORE(1, 1);
    __syncthreads();
    {
        LAS const unsigned char* Kb = lds + r * AT_KP + hh * 16;
#pragma unroll
        for (int i = 0; i < 16; ++i) { sc0[i] = 0.f; sc1[i] = 0.f; }
#pragma unroll
        for (int ks = 0; ks < 8; ++ks) { bf16x8 a0, a1, qf; AT_FRAG_LD(a0, a1, qf, Kb, Qb, ks); sc0 = AT_MFMA(a0, AT_QSEL(qf, ks), sc0); sc1 = AT_MFMA(a1, AT_QSEL(qf, ks), sc1); }
        AT_BIAS_MAX(sc0, sc1, 0, 0, -(NT - 4), mxc);
    }
    __syncthreads();
    int v0 = 0, v1 = 1, v2 = 2;
    for (int t = 0; t < NT; ++t) {
        if (t + 2 < NT) AT_LOAD(t + 2);
        const int wlim = wid >> 1;
        const bool act = (t - (NT - 4)) <= wlim, actn = (t + 1 < NT) && ((t + 1 - (NT - 4)) <= wlim);
        if (act) {
            if (t == 0 || __any(mxc > AT_THR)) {
                const float dl = (t == 0) ? mxc : fmaxf(mxc, 0.f);
                mref += dl;
#pragma unroll
                for (int i = 0; i < 16; ++i) { sc0[i] -= dl; sc1[i] -= dl; }
                if (t != 0) {
                    const float alpha = fexp2(-dl);
                    lrun *= alpha;
#pragma unroll
                    for (int d = 0; d < 4; ++d)
#pragma unroll
                        for (int i = 0; i < 16; ++i) o[d][i] *= alpha;
                }
            }
            f32x16 sn0, sn1; float mxn = 0.f; float ls = 0.f; u32x4 pw[4];
            {
                LAS const unsigned char* Kb = lds + ((t + 1) & 1) * AT_KBUF + r * AT_KP + hh * 16;
                const float nm = -mref;
#pragma unroll
                for (int i = 0; i < 16; ++i) { sn0[i] = nm; sn1[i] = nm; }
                bf16x8 fa0[2], fa1[2], fq[2];
                AT_SB();
                AT_FRAG_LD(fa0[0], fa1[0], fq[0], Kb, Qb, 0);
#pragma unroll
                for (int ks = 0; ks < 8; ++ks) {
                    if (ks < 7) AT_FRAG_LD(fa0[(ks + 1) & 1], fa1[(ks + 1) & 1], fq[(ks + 1) & 1], Kb, Qb, ks + 1);
                    sn0 = AT_MFMA(fa0[ks & 1], AT_QSEL(fq[ks & 1], ks), sn0); sn1 = AT_MFMA(fa1[ks & 1], AT_QSEL(fq[ks & 1], ks), sn1);
                    AT_EXP_STEP(sc0, sc1, ks);
                }
#pragma unroll
                for (int ks = 0; ks < 8; ++ks) {
                    __builtin_amdgcn_sched_group_barrier(0x100, 3, 0);
                    __builtin_amdgcn_sched_group_barrier(0x008, 1, 0);
                    __builtin_amdgcn_sched_group_barrier(0x400, 2, 0);
                    __builtin_amdgcn_sched_group_barrier(0x002, 3, 0);
                    __builtin_amdgcn_sched_group_barrier(0x008, 1, 0);
                    __builtin_amdgcn_sched_group_barrier(0x400, 2, 0);
                    __builtin_amdgcn_sched_group_barrier(0x002, 3, 0);
                }
                AT_SB();
            }
            lrun += ls;
            LAS const unsigned char* Vb = lds + AT_VOFF + v0 * AT_VBUF + r * AT_VP + hh * 16;
            {
                bf16x8 fv[2];
                fv[0] = *(LAS const bf16x8*)(Vb);
                AT_SB();
#pragma unroll
                for (int i = 0; i < 16; ++i) {
                    const int s_ = i >> 2, d_ = i & 3;
                    if (i < 15) { const int sn_ = (i + 1) >> 2, dn_ = (i + 1) & 3; fv[(i + 1) & 1] = *(LAS const bf16x8*)(Vb + dn_ * 32 * AT_VP + sn_ * 32); }
                    o[d_] = AT_MFMA(fv[i & 1], __builtin_bit_cast(bf16x8, pw[s_]), o[d_]);
                    if ((i & 3) == 3) { if (actn) AT_BIAS_G(sn0, sn1, (t + 1) & 1, s_); AT_SB(); }
                }
            }
            if (actn) {
                AT_MASK_MAX(sn0, sn1, t + 1, t + 1 - (NT - 4), mxn);
                sc0 = sn0; sc1 = sn1; mxc = mxn;
            }
        }
        if (t + 2 < NT) AT_STORE(t & 1, v2);
        __syncthreads();
        const int tmp = v0; v0 = v1; v1 = v2; v2 = tmp;
    }
    const float ltot = lrun + __shfl_xor(lrun, 32);
    const float inv = 1.f / ltot;
    bf16_t* Op = O + ((size_t)(b * SEQ + q_row)) * DM + h * 128 + 4 * hh;
#pragma unroll
    for (int d = 0; d < 4; ++d)
#pragma unroll
        for (int g = 0; g < 4; ++g) { u32x2 w; w.x = cvt_pk_bf16(o[d][4 * g] * inv, o[d][4 * g + 1] * inv); w.y = cvt_pk_bf16(o[d][4 * g + 2] * inv, o[d][4 * g + 3] * inv);
            *(u32x2*)(Op + d * 32 + 8 * g) = w; }
#undef AT_LOAD
#undef AT_STORE
}

__device__ __forceinline__ void transpose_load(float (&v)[32], const float* W, int N, int item, int lane) {
    const int nblk = N / 32, kb = item / nblk, nb = item % nblk, k0 = 64 * kb, n0 = 32 * nb;
    const float* p = W + (size_t)(k0 + (lane >> 5)) * N + n0 + (lane & 31);
#pragma unroll
    for (int i = 0; i < 32; ++i) v[i] = p[(size_t)(2 * i) * N];
}
__device__ __forceinline__ void transpose_store(const float (&v)[32], const float* gain, int K, int N, bf16_t* WT, int row_off, LAS float* scr, int item, int lane) {
    const int nblk = N / 32, kb = item / nblk, nb = item % nblk, k0 = 64 * kb, n0 = 32 * nb;
#pragma unroll
    for (int i = 0; i < 32; ++i) scr[(2 * i + (lane >> 5)) * 33 + (lane & 31)] = v[i];
    const int c = lane & 7;
    f32x4 g0 = (f32x4){1.f, 1.f, 1.f, 1.f}, g1 = g0;
    if (gain) { g0 = *(const f32x4*)(gain + k0 + 8 * c); g1 = *(const f32x4*)(gain + k0 + 8 * c + 4); }
    asm volatile("s_waitcnt lgkmcnt(0)" ::: "memory");
#pragma unroll
    for (int j = 0; j < 4; ++j) { const int n = (lane >> 3) + 8 * j; const LAS float* s = scr + (8 * c) * 33 + n;
        u32x4 o; o.x = pk2(s[0 * 33] * g0.x, s[1 * 33] * g0.y); o.y = pk2(s[2 * 33] * g0.z, s[3 * 33] * g0.w); o.z = pk2(s[4 * 33] * g1.x, s[5 * 33] * g1.y); o.w = pk2(s[6 * 33] * g1.z, s[7 * 33] * g1.w);
        *(u32x4*)(WT + (size_t)(row_off + n0 + n) * K + k0 + 8 * c) = o; }
    asm volatile("s_waitcnt lgkmcnt(0)" ::: "memory");
}
__device__ __forceinline__ void transpose_job(const float* W, const float* gain, int K, int N, bf16_t* WT, int row_off, LAS float* scr, int it, int ni, int step, int lane) {
    float va[32], vb[32];
    if (it < ni) transpose_load(va, W, N, it, lane);
    while (it < ni) {
        int nx = it + step;
        if (nx < ni) transpose_load(vb, W, N, nx, lane);
        transpose_store(va, gain, K, N, WT, row_off, scr, it, lane);
        it = nx; if (it >= ni) break;
        nx = it + step;
        if (nx < ni) transpose_load(va, W, N, nx, lane);
        transpose_store(vb, gain, K, N, WT, row_off, scr, it, lane);
        it = nx;
    }
}
__device__ __forceinline__ void rms_rows_bf16(const float* src, const float* g, bf16_t* dst, int gw, int NGW, int lane) {
    for (int mrow = gw; mrow < MTOK; mrow += NGW) {
        const f32x4* xr = (const f32x4*)(src + (size_t)mrow * DM) + lane; f32x4 v[8]; float s = 0.f;
#pragma unroll
        for (int j = 0; j < 8; ++j) { v[j] = xr[64 * j]; s += (v[j].x * v[j].x + v[j].y * v[j].y) + (v[j].z * v[j].z + v[j].w * v[j].w); }
        const float rstd = 1.f / sqrtf(wave_sum(s) * (1.f / DM) + RMS_EPS);
        u32x2* o8 = (u32x2*)(dst + (size_t)mrow * DM) + lane;
#pragma unroll
        for (int j = 0; j < 8; ++j) { const f32x4 gg = ((const f32x4*)g)[lane + 64 * j]; u32x2 w; w.x = cvt_pk_bf16(v[j].x * rstd * gg.x, v[j].y * rstd * gg.y); w.y = cvt_pk_bf16(v[j].z * rstd * gg.z, v[j].w * rstd * gg.w); o8[64 * j] = w; }
    }
}

#define XB_TMO      128
#define XB_XCNT(j)  (256  + 64 * (j))
#define XB_XSUB(j)  (1280 + 64 * (j))
#define XB_XGEN(j)  (2304 + 64 * (j))
#define XB_TOP      3328
#define XB_TOPGEN   3392
#define XCD_BAR_WORDS 3456
#define XB_SPIN_CAP (1u << 18)

__device__ __forceinline__ unsigned xb_ld(unsigned* p)              { return __hip_atomic_load(p, __ATOMIC_RELAXED, __HIP_MEMORY_SCOPE_AGENT); }
__device__ __forceinline__ unsigned xb_add(unsigned* p, unsigned v) { return __hip_atomic_fetch_add(p, v, __ATOMIC_RELAXED, __HIP_MEMORY_SCOPE_AGENT); }
__device__ __forceinline__ unsigned xb_xcc_id() { return (unsigned)__builtin_amdgcn_s_getreg((3 << 11) | 20) & 0xFu; }
#define XB_SPIN(cond, bar) do { unsigned _sp = 0; while (cond) { __builtin_amdgcn_s_sleep(1); \
    if ((++_sp & 255u) == 0u) { if (xb_ld(&(bar)[XB_TMO])) break; if (_sp > XB_SPIN_CAP) { atomicAdd(&(bar)[XB_TMO], 1u); break; } } } } while (0)

struct XcdBarrier {
    unsigned* bar; unsigned x;
    volatile LAS unsigned* st;
};

__device__ __forceinline__ XcdBarrier xcd_barrier_post(unsigned* bar, volatile LAS unsigned* st) {
    XcdBarrier b; b.bar = bar; b.x = xb_xcc_id(); b.st = st;
    if (threadIdx.x == 0) (void)xb_add(&bar[XB_XCNT(b.x)], 1u);
    return b;
}
__device__ __forceinline__ void xcd_barrier_complete(unsigned* bar, unsigned x, unsigned& nloc, unsigned& nx) {
    const unsigned G = gridDim.x * gridDim.y * gridDim.z;
    unsigned sum, cnt, mine, sp = 0u;
    for (;;) {
        sum = 0u; cnt = 0u; mine = 0u;
#pragma unroll
        for (unsigned j = 0; j < 16; ++j) { const unsigned c = xb_ld(&bar[XB_XCNT(j)]); sum += c; cnt += (c > 0u) ? 1u : 0u; mine = (j == x) ? c : mine; }
        if (sum == G) break;
        __builtin_amdgcn_s_sleep(1);
        if ((++sp & 255u) == 0u) { if (xb_ld(&bar[XB_TMO])) break; if (sp > XB_SPIN_CAP) { atomicAdd(&bar[XB_TMO], 1u); break; } }
    }
    nloc = mine > 0u ? mine : 1u; nx = cnt > 0u ? cnt : 1u;
}

__device__ __forceinline__ void xcd_barrier(const XcdBarrier& b) {
    asm volatile("s_waitcnt vmcnt(0)" ::: "memory");
    __syncthreads();
    if (threadIdx.x == 0) {
        unsigned* bar = b.bar;
        __builtin_amdgcn_s_waitcnt(0);
        unsigned nloc = b.st[0], nx = b.st[1];
        if (nloc == 0u) { xcd_barrier_complete(bar, b.x, nloc, nx); b.st[0] = nloc; b.st[1] = nx; }
        const unsigned old = xb_add(&bar[XB_XSUB(b.x)], 1u);
        const unsigned gen = old / nloc;
        if (old + 1u == (gen + 1u) * nloc) {
            __builtin_amdgcn_fence(__ATOMIC_RELEASE, "agent");
            asm volatile("s_waitcnt vmcnt(0)" ::: "memory");
            const unsigned og = xb_add(&bar[XB_TOP], 1u);
            const unsigned tg = og / nx;
            if (og + 1u == (tg + 1u) * nx) xb_add(&bar[XB_TOPGEN], 1u);
            else XB_SPIN(xb_ld(&bar[XB_TOPGEN]) == tg, bar);
            __builtin_amdgcn_fence(__ATOMIC_ACQUIRE, "agent");
            xb_add(&bar[XB_XGEN(b.x)], 1u);
            asm volatile("s_waitcnt vmcnt(0)" ::: "memory");
        } else {
            XB_SPIN(xb_ld(&bar[XB_XGEN(b.x)]) == gen, bar);
            __builtin_amdgcn_fence(__ATOMIC_ACQUIRE, "agent");
            asm volatile("s_waitcnt vmcnt(0)" ::: "memory");
        }
    }
    __syncthreads();
}


constexpr int N_PHASES = 23;
#ifndef PH_MASK
#define PH_MASK 0xffffffffu
#endif
#define PHON(k) ((PH_MASK >> (k)) & 1u)
#ifndef REPEAT_MASK
#define REPEAT_MASK 0u
#endif
#ifndef EXTRA_SYNCS
#define EXTRA_SYNCS 0
#endif
__global__ void __launch_bounds__(NTHREADS, 2) trunk_fwd(Params Pk) {
    extern __shared__ __attribute__((aligned(16))) unsigned char lds_raw[];
    LAS unsigned char* lds = (LAS unsigned char*)lds_raw;
    const int ph_lo = Pk.ph_lo, ph_hi = Pk.ph_hi;
    const int wave_s = __builtin_amdgcn_readfirstlane((int)threadIdx.x >> 6);
    volatile LAS unsigned* xb_st = (volatile LAS unsigned*)(lds + 144 * 1024);
    if (threadIdx.x < 2) xb_st[threadIdx.x] = 0u;
    __syncthreads();
    if (ph_hi - ph_lo > 1) (void)xcd_barrier_post((unsigned*)(Pk.ws + WS_BAR), xb_st);

    for (int ph = ph_lo; ph < ph_hi; ++ph) for (int rep = 0; rep < 1 + (int)((REPEAT_MASK >> ph) & 1u); ++rep) {
        if (ph == 5 || ph == 19) continue;
        if (ph != ph_lo || rep) {
            if (ph == 1 && rep == 0) cg::this_grid().sync();
            else { XcdBarrier xb; xb.bar = (unsigned*)((*(const __attribute__((address_space(4))) Params*)__builtin_amdgcn_kernarg_segment_ptr()).ws + WS_BAR); xb.x = xb_xcc_id(); xb.st = xb_st; xcd_barrier(xb); }
        }
        if (EXTRA_SYNCS && ph == 2 && rep == 0) { for (int e = 0; e < EXTRA_SYNCS; ++e) { XcdBarrier xb; xb.bar = (unsigned*)((*(const __attribute__((address_space(4))) Params*)__builtin_amdgcn_kernarg_segment_ptr()).ws + WS_BAR); xb.x = xb_xcc_id(); xb.st = xb_st; xcd_barrier(xb); } }
        const __attribute__((address_space(4))) Params* Pp = (const __attribute__((address_space(4))) Params*)__builtin_amdgcn_kernarg_segment_ptr(); asm volatile("" : "+s"(Pp));
#define P (*Pp)
        unsigned char* ws = P.ws;
        float* cosT = (float*)(ws + WS_COS); float* sinT = (float*)(ws + WS_SIN); float* LF = (float*)(ws + WS_LF); float* C2 = (float*)(ws + WS_C2); float* SS = (float*)(ws + WS_SS); float* RS = (float*)(ws + WS_RS); float* PS = (float*)(ws + WS_PS);
        bf16_t* XN = (bf16_t*)(ws + WS_XN);
        float* H = P.out;
        int lane; asm volatile("v_mbcnt_lo_u32_b32 %0, -1, 0\n\tv_mbcnt_hi_u32_b32 %0, -1, %0" : "=v"(lane));
        int wave = wave_s; asm volatile("" : "+s"(wave));
        const int tid = wave * 64 + lane;
        int bx = blockIdx.x; asm volatile("" : "+s"(bx));
        int G = gridDim.x; asm volatile("" : "+s"(G));
        const int NGW = G * NWAVES, NGT = G * NTHREADS;
        const int gw = bx * NWAVES + wave, gt = bx * NTHREADS + tid;
        if (ph == 0 && PHON(0)) {
            LAS float* scr = (LAS float*)(lds + wave * 8448);
            LAS unsigned char* gtab = lds + 69632;
            for (int E = tid; E < 4096; E += NTHREADS) {
                const int j = E >> 9, q = (E >> 6) & 7, lk = E & 63, k0 = 4 * lk + 256 * j;
                const f32x4 g4 = *(const f32x4*)(P.fox_norm + k0);
                float wa[4], wb[4];
#pragma unroll
                for (int i = 0; i < 4; ++i) { wa[i] = P.fox_wf[(k0 + i) * 16 + 2 * q] * g4[i]; wb[i] = P.fox_wf[(k0 + i) * 16 + 2 * q + 1] * g4[i]; }
                u32x4 w; w.x = pk2(wa[0], wa[1]); w.y = pk2(wa[2], wa[3]); w.z = pk2(wb[0], wb[1]); w.w = pk2(wb[2], wb[3]);
                *(LAS u32x4*)(gtab + E * 16) = w;
            }
            __syncthreads();
            int base = 0;
#pragma unroll 1
            for (int j = 0; j < 13; ++j) {
                const float* W_; const float* G_ = nullptr; int K_ = DM, N_ = DM, OFF_ = 0; size_t WT_;
                switch (j) {
                    case 0: W_ = P.fox_wq; G_ = P.fox_norm; WT_ = WS_FQKF; break;
                    case 1: W_ = P.fox_wk; G_ = P.fox_norm; WT_ = WS_FQKF; OFF_ = 2048; break;
                    case 2: W_ = P.fox_wv; G_ = P.fox_norm; WT_ = WS_FWV; break;
                    case 3: W_ = P.fox_wo; WT_ = WS_FWO; break;
                    case 4: W_ = P.mlp_up; G_ = P.mlp_norm; N_ = DFF; WT_ = WS_UP0; break;
                    case 5: W_ = P.mlp_down; K_ = DFF; WT_ = WS_DN0; break;
                    case 6: W_ = P.ret_wq; G_ = P.ret_norm; WT_ = WS_RWQKG; break;
                    case 7: W_ = P.ret_wk; G_ = P.ret_norm; WT_ = WS_RWQKG; OFF_ = 2048; break;
                    case 8: W_ = P.ret_wg; G_ = P.ret_norm; N_ = 4096; WT_ = WS_RWQKG; OFF_ = 4096; break;
                    case 9: W_ = P.ret_wv; G_ = P.ret_norm; N_ = 4096; WT_ = WS_RWV; break;
                    case 10: W_ = P.ret_wo; K_ = 4096; WT_ = WS_RWO; break;
                    case 11: W_ = P.mlp_up + (size_t)DM * DFF; G_ = P.mlp_norm + DM; N_ = DFF; WT_ = WS_UP1; break;
                    default: W_ = P.mlp_down + (size_t)DM * DFF; K_ = DFF; WT_ = WS_DN1; break;
                }
                const int ni = (K_ / 64) * (N_ / 32); int it = gw - (base % NGW); if (it < 0) it += NGW;
                transpose_job(W_, G_, K_, N_, (bf16_t*)(ws + WT_), OFF_, scr, it, ni, NGW, lane); base += ni;
            }
            for (int i = gt; i < SEQ * 128; i += NGT) { const int s = i >> 7, j = i & 127; const float inv = powf(10000.f, -(float)j / 128.f); const float ang = (float)s * inv; cosT[i] = cosf(ang); sinT[i] = sinf(ang); }
            for (int mrow = gw; mrow < MTOK; mrow += NGW) {
                const f32x4* xr = (const f32x4*)(P.x + (size_t)mrow * DM) + lane; f32x4 v[8]; float sq = 0.f;
#pragma unroll
                for (int j = 0; j < 8; ++j) { v[j] = xr[64 * j]; sq += (v[j].x * v[j].x + v[j].y * v[j].y) + (v[j].z * v[j].z + v[j].w * v[j].w); }
                sq = wave_sum(sq);
                const float rstd = 1.f / sqrtf(sq * (1.f / DM) + RMS_EPS);
                if (lane == 0) RS[mrow] = rstd;
                {
                    float ga[16];
#pragma unroll
                    for (int hq = 0; hq < 16; ++hq) ga[hq] = 0.f;
#pragma unroll
                    for (int j = 0; j < 8; ++j)
#pragma unroll
                        for (int q = 0; q < 8; ++q) {
                            const u32x4 w = *(LAS const u32x4*)(gtab + ((j * 8 + q) * 64 + lane) * 16);
                            ga[2 * q] += v[j].x * __builtin_bit_cast(float, w.x << 16) + v[j].y * __builtin_bit_cast(float, w.x & 0xffff0000u)
                                       + v[j].z * __builtin_bit_cast(float, w.y << 16) + v[j].w * __builtin_bit_cast(float, w.y & 0xffff0000u);
                            ga[2 * q + 1] += v[j].x * __builtin_bit_cast(float, w.z << 16) + v[j].y * __builtin_bit_cast(float, w.z & 0xffff0000u)
                                           + v[j].z * __builtin_bit_cast(float, w.w << 16) + v[j].w * __builtin_bit_cast(float, w.w & 0xffff0000u);
                            if ((q & 3) == 3) __builtin_amdgcn_sched_barrier(0);
                        }
                    float zsel = 0.f;
#pragma unroll
                    for (int hq = 0; hq < 16; ++hq) { const float t_ = wave_sum(ga[hq]); zsel = (lane == hq) ? t_ : zsel; }
                    if (lane < 16) { const float z = zsel * rstd + P.fox_bf[lane]; LF[(size_t)mrow * 16 + lane] = fminf(z, 0.f) - log1pf(expf(-fabsf(z))); }
                }
                u32x2* o8 = (u32x2*)(XN + (size_t)mrow * DM) + lane;
#pragma unroll
                for (int j = 0; j < 8; ++j) { u32x2 pk; pk.x = cvt_pk_bf16(v[j].x, v[j].y); pk.y = cvt_pk_bf16(v[j].z, v[j].w); o8[64 * j] = pk; }
            }
        }
        else if (ph == 1 && PHON(1)) {
            const SchedF1 S{(const char*)XN, (const char*)(ws + WS_FQKF), (const char*)(ws + WS_FWV), G, bx};
            const EpiF1 E{(bf16_t*)(ws + WS_FQ), (bf16_t*)(ws + WS_FK), (bf16_t*)(ws + WS_FVT), LF, P.fox_bf, 0.08838834764831845f * LOG2E, RS};
            pg::gemm_phase(lds, tid, pg::Cfg{DM, DM, 32, 32}, S, E);
        }
        else if (ph == 2 && PHON(2)) {
            LAS float* wtot = (LAS float*)lds;
            for (int bh = bx; bh < 64; bh += G) {
                const int b = bh >> 4, h = bh & 15;
                float v[8]; float run = 0.f;
#pragma unroll
                for (int i = 0; i < 8; ++i) { run += LF[(size_t)(b * SEQ + tid * 8 + i) * 16 + h]; v[i] = run; }
                float incl = run;
#pragma unroll
                for (int o = 1; o < 64; o <<= 1) { const float t = __shfl_up(incl, o); if (lane >= o) incl += t; }
                if (lane == 63) wtot[wave] = incl;
                __syncthreads();
                float off = incl - run;
                for (int w = 0; w < wave; ++w) off += wtot[w];
#pragma unroll
                for (int i = 0; i < 8; ++i) C2[(size_t)bh * SEQ + tid * 8 + i] = (v[i] + off) * LOG2E;
                __syncthreads();
            }
        }
        else if (ph == 3 && PHON(3)) {
            const int vcu = (G % 8 == 0) ? (bx % 8) * (G / 8) + bx / 8 : bx;
            for (int p = vcu; p < 512; p += G) {
                const int bh = p >> 3, s = p & 7;
                attn_unit(lds, tid, bh, 15 - s, (const bf16_t*)(ws + WS_FQ), (const bf16_t*)(ws + WS_FK), (const bf16_t*)(ws + WS_FVT), C2, (bf16_t*)(ws + WS_FO));
                attn_unit(lds, tid, bh, s, (const bf16_t*)(ws + WS_FQ), (const bf16_t*)(ws + WS_FK), (const bf16_t*)(ws + WS_FVT), C2, (bf16_t*)(ws + WS_FO));
            }
        }
        else if (ph == 4 && PHON(4)) {
            const SchedPlain S{(const char*)(ws + WS_FO), (const char*)(ws + WS_FWO), 64, 8, (size_t)256 * DM * 2, (size_t)256 * DM * 2, G, bx};
            pg::gemm_phase(lds, tid, pg::Cfg{DM, DM, 32, 32}, S, EpiResT<true>{P.x, XN, PS, 1});
        }
        else if ((ph == 5 || ph == 8 || ph == 19) && PHON(5)) {
            for (int mrow = gt; mrow < MTOK; mrow += NGT) {
                const f32x4* pp = (const f32x4*)(PS + (size_t)mrow * 32); float tot = 0.f;
#pragma unroll
                for (int j = 0; j < 8; ++j) { const f32x4 a = pp[j]; tot += (a.x + a.y) + (a.z + a.w); }
                RS[mrow] = 1.f / sqrtf(tot * (1.f / DM) + RMS_EPS);
            }
        }
        else if ((ph == 6 || ph == 20) && PHON(6)) {
            const SchedPlain S{(const char*)XN, (const char*)(ws + (ph == 6 ? WS_UP0 : WS_UP1)), 64, 32, (size_t)256 * DM * 2, (size_t)256 * DM * 2, G, bx};
            pg::gemm_phase(lds, tid, pg::Cfg{DM, DM, 32, 32}, S, EpiUp{(bf16_t*)(ws + WS_U), PS});
        }
        else if ((ph == 7 || ph == 21) && PHON(7)) {
            const SchedPlain S{(const char*)(ws + WS_U), (const char*)(ws + (ph == 7 ? WS_DN0 : WS_DN1)), 64, 8, (size_t)256 * DFF * 2, (size_t)256 * DFF * 2, G, bx};
            pg::gemm_phase(lds, tid, pg::Cfg{DFF, DFF, 128, 128}, S, EpiRes{nullptr, XN, PS, ph == 7 ? 1 : 0});
        }
        else if (ph >= 9 && ph <= 16) {
            const int hb = (ph - 9) >> 2, sub = (ph - 9) & 3;
            bf16_t* QR = (bf16_t*)(ws + WS_QR); bf16_t* KR = (bf16_t*)(ws + WS_KR); bf16_t* KT = (bf16_t*)(ws + WS_KT); bf16_t* VDT = (bf16_t*)(ws + WS_VDT); bf16_t* ST = (bf16_t*)(ws + WS_ST); bf16_t* Gt = (bf16_t*)(ws + WS_G);
            if (sub == 0 && PHON(9)) {
                const SchedR1 S{(const char*)(XN + (size_t)hb * 8192 * DM), (const char*)(ws + WS_RWQKG), (const char*)(ws + WS_RWV), G, bx};
                const EpiR1 E{QR, KR, KT, Gt, VDT, cosT, sinT, hb, RS};
                pg::gemm_phase(lds, tid, pg::Cfg{DM, DM, 32, 32}, S, E);
            } else if (sub == 1 && PHON(10)) {
                const SchedR2 S{(const char*)QR, (const char*)KR, (const char*)KT, (const char*)VDT, G, bx};
                pg::gemm_phase(lds, tid, pg::Cfg{256, 256, 4, 4}, S, EpiR2{KR, ST});
            } else if (sub == 2 && PHON(11)) {
                for (int id = gt; id < 16 * 16384; id += NGT) {
                    const int bhl = id >> 14, rem = id & 16383;
                    const float gC = fexp2(256.f * ret_lg2(bhl & 7));
                    bf16_t* p0 = ST + (size_t)bhl * 17 * 131072 + (size_t)rem * 8;
                    { unsigned zv = 0u; asm volatile("" : "+v"(zv)); *(u32x4*)p0 = (u32x4){zv, zv, zv, zv}; }
                    u32x4 uv[15];
#pragma unroll
                    for (int n = 0; n < 15; ++n) uv[n] = *(const u32x4*)(p0 + (size_t)(n + 1) * 131072);
                    float s[8];
#pragma unroll
                    for (int e = 0; e < 8; ++e) s[e] = 0.f;
#pragma unroll
                    for (int n = 0; n < 15; ++n) {
                        const unsigned w[4] = {uv[n].x, uv[n].y, uv[n].z, uv[n].w};
#pragma unroll
                        for (int q = 0; q < 4; ++q) { s[2 * q] = s[2 * q] * gC + __builtin_bit_cast(float, w[q] << 16); s[2 * q + 1] = s[2 * q + 1] * gC + __builtin_bit_cast(float, w[q] & 0xffff0000u); }
                        u32x4 ov; ov.x = cvt_pk_bf16(s[0], s[1]); ov.y = cvt_pk_bf16(s[2], s[3]); ov.z = cvt_pk_bf16(s[4], s[5]); ov.w = cvt_pk_bf16(s[6], s[7]);
                        *(u32x4*)(p0 + (size_t)(n + 1) * 131072) = ov;
                    }
                }
            } else if (sub == 3 && PHON(12)) {
                const SchedR4 S{(const char*)KR, (const char*)QR, (const char*)VDT, (const char*)ST, G, bx};
                pg::gemm_phase(lds, tid, pg::Cfg{256, 256, 8, 4}, S, EpiR4{Gt, SS, P.ret_gn, hb});
            }
        }
        else if (ph == 17 && PHON(17)) {
            float* RAT = (float*)(ws + WS_RAT);
            for (int mrow = gt; mrow < MTOK; mrow += NGT) {
                float rs[8];
#pragma unroll
                for (int h = 0; h < 8; ++h) { const float* sp = SS + ((size_t)mrow * 8 + h) * 8; const f32x4 a = *(const f32x4*)sp, b = *(const f32x4*)(sp + 4);
                    rs[h] = 1.f / sqrtf((((a.x + a.y) + (a.z + a.w)) + ((b.x + b.y) + (b.z + b.w))) * (1.f / 512.f) + RMS_EPS); }
                f32x4 o0, o1;
                o0.x = rs[0] / rs[1]; o0.y = rs[1] / rs[2]; o0.z = rs[2] / rs[3]; o0.w = rs[3] / rs[4];
                o1.x = rs[4] / rs[5]; o1.y = rs[5] / rs[6]; o1.z = rs[6] / rs[7]; o1.w = rs[7];
                *(f32x4*)(RAT + (size_t)mrow * 8) = o0; *(f32x4*)(RAT + (size_t)mrow * 8 + 4) = o1;
            }
        }
        else if (ph == 18 && PHON(18)) {
            const SchedPlain S{(const char*)(ws + WS_G), (const char*)(ws + WS_RWO), 64, 8, (size_t)256 * 4096 * 2, (size_t)256 * 4096 * 2, G, bx};
            EpiResHook E; E.basef = nullptr; E.HB = XN; E.PS = PS; E.ps_on = 1; E.RAT = (const float*)(ws + WS_RAT);
            pg::gemm_phase(lds, tid, pg::Cfg{4096, 4096, 64, 64}, S, E);
        }
        else if (ph == 22 && PHON(22)) {
            for (int mrow = gw; mrow < MTOK; mrow += NGW) {
                const u32x2* hr = (const u32x2*)(XN + (size_t)mrow * DM) + lane; f32x4 v[8]; float s = 0.f;
#pragma unroll
                for (int j = 0; j < 8; ++j) { const u32x2 hv = hr[64 * j];
                    v[j].x = __builtin_bit_cast(float, hv.x << 16); v[j].y = __builtin_bit_cast(float, hv.x & 0xffff0000u); v[j].z = __builtin_bit_cast(float, hv.y << 16); v[j].w = __builtin_bit_cast(float, hv.y & 0xffff0000u);
                    s += (v[j].x * v[j].x + v[j].y * v[j].y) + (v[j].z * v[j].z + v[j].w * v[j].w); }
                const float rstd = 1.f / sqrtf(wave_sum(s) * (1.f / DM) + RMS_EPS);
                f32x4* xr = (f32x4*)(H + (size_t)mrow * DM) + lane;
#pragma unroll
                for (int j = 0; j < 8; ++j) { const f32x4 gg = ((const f32x4*)P.final_norm)[lane + 64 * j]; xr[64 * j] = v[j] * rstd * gg; }
            }
        }
    }
}

extern "C" void kernel_launch(void* const* d_in, const int* in_sizes, int n_in, void* d_out, int out_size, void* d_ws, size_t ws_size, hipStream_t stream) {
    static int grid = 0;
    if (grid == 0) {
        if (n_in != 19 || out_size != MTOK * DM || ws_size < WS_END) { fprintf(stderr, "kernel_launch: unexpected sizes (n_in %d out %d ws %zu)\n", n_in, out_size, ws_size); grid = -1; return; }
        int dev = 0, cus = 0, per_cu = 0;
        hipGetDevice(&dev); hipDeviceGetAttribute(&cus, hipDeviceAttributeMultiprocessorCount, dev);
        if (hipFuncSetAttribute((const void*)trunk_fwd, hipFuncAttributeMaxDynamicSharedMemorySize, LDS_BYTES) != hipSuccess) { fprintf(stderr, "kernel_launch: hipFuncSetAttribute failed\n"); grid = -1; return; }
        if (hipOccupancyMaxActiveBlocksPerMultiprocessor(&per_cu, (const void*)trunk_fwd, NTHREADS, LDS_BYTES) != hipSuccess || per_cu < 1) per_cu = 1;
        (void)hipGetLastError();
        grid = cus * per_cu;
        if (grid <= 0) grid = 256;
    }
    if (grid < 0) return;
    Params p{};
    const float** pf = (const float**)&p;
    for (int i = 0; i < 19; ++i) pf[i] = (const float*)d_in[i];
    p.out = (float*)d_out; p.ws = (unsigned char*)d_ws;
#if MK_PER_PHASE
    for (int ph = 0; ph < N_PHASES; ++ph) {
        p.ph_lo = ph; p.ph_hi = ph + 1;
        hipLaunchKernelGGL(trunk_fwd, dim3(grid), dim3(NTHREADS), LDS_BYTES, stream, p);
    }
#else
    p.ph_lo = 0; p.ph_hi = N_PHASES;
    if (hipMemsetAsync((char*)d_ws + WS_BAR, 0, 16384, stream) != hipSuccess) { fprintf(stderr, "kernel_launch: hipMemsetAsync failed\n"); return; }
    void* args[] = {&p};
    hipError_t e = hipLaunchCooperativeKernel((const void*)trunk_fwd, dim3(grid), dim3(NTHREADS), args, LDS_BYTES, stream);
    if (e != hipSuccess) fprintf(stderr, "cooperative launch failed: %s (grid %d)\n", hipGetErrorString(e), grid);
#endif
}
```

```cpp
#include <hip/hip_runtime.h>
#include <hip/hip_cooperative_groups.h>
#include <cstdio>
#include <cstdint>
namespace cg = cooperative_groups;

#ifndef MK_PER_PHASE
#define MK_PER_PHASE 0
#endif

#define LAS __attribute__((address_space(3)))
typedef unsigned short bf16_t;
typedef short bf16x8 __attribute__((ext_vector_type(8)));
typedef short s16x4 __attribute__((ext_vector_type(4)));
typedef float f32x4 __attribute__((ext_vector_type(4)));
typedef float f32x16 __attribute__((ext_vector_type(16)));
typedef unsigned u32x4 __attribute__((ext_vector_type(4)));
typedef unsigned u32x2 __attribute__((ext_vector_type(2)));

constexpr int MTOK = 16384, DM = 2048, SEQ = 4096, DFF = 8192;
constexpr float RMS_EPS = 1e-6f;
constexpr float LOG2E = 1.4426950408889634f;
constexpr int NTHREADS = 512, NWAVES = 8;
constexpr int LDS_BYTES = 144 * 1024 + 256;

constexpr size_t MiB = 1u << 20;
constexpr size_t WS_RS = 0, WS_BAR = 128 * 1024, WS_RAT = 256 * 1024, WS_COS = 1 * MiB, WS_SIN = 3 * MiB, WS_LF = 5 * MiB, WS_C2 = 6 * MiB, WS_SS = 7 * MiB, WS_PS = 7 * MiB;
constexpr size_t WS_RWQKG = 12 * MiB;
constexpr size_t WS_RWV = 44 * MiB;
constexpr size_t WS_RWO = 60 * MiB;
constexpr size_t WS_UP1 = 76 * MiB, WS_DN1 = 108 * MiB;
constexpr size_t WS_FQKF = 140 * MiB;
constexpr size_t WS_FWV = 157 * MiB, WS_FWO = 165 * MiB, WS_UP0 = 173 * MiB, WS_DN0 = 205 * MiB;
constexpr size_t WS_XN = 237 * MiB;
constexpr size_t WS_FQ = 301 * MiB, WS_FK = 365 * MiB, WS_FVT = 429 * MiB, WS_FO = 493 * MiB;
constexpr size_t WS_U = 301 * MiB;
constexpr size_t WS_G = 301 * MiB;
constexpr size_t WS_VDT = 140 * MiB;
constexpr size_t WS_QR = 204 * MiB;
constexpr size_t WS_KR = 429 * MiB;
constexpr size_t WS_KT = 461 * MiB;
constexpr size_t WS_ST = 493 * MiB;
constexpr size_t WS_END = 576 * MiB;
static_assert(WS_ST + 68 * MiB <= WS_END, "ws map");

struct Params {
    const float* x; const float* fox_norm; const float* fox_wq; const float* fox_wk; const float* fox_wv; const float* fox_wf; const float* fox_bf; const float* fox_wo;
    const float* ret_norm; const float* ret_wq; const float* ret_wk; const float* ret_wv; const float* ret_wg; const float* ret_gn; const float* ret_wo;
    const float* mlp_norm; const float* mlp_up; const float* mlp_down; const float* final_norm;
    float* out; unsigned char* ws; int ph_lo, ph_hi;
};

typedef float cv_f32x2 __attribute__((ext_vector_type(2))); typedef __bf16 cv_bf16x2 __attribute__((ext_vector_type(2)));
__device__ __forceinline__ unsigned cvt_pk_bf16(float lo, float hi) { cv_f32x2 v = {lo, hi}; cv_bf16x2 b = __builtin_convertvector(v, cv_bf16x2); return __builtin_bit_cast(unsigned, b); }
__device__ __forceinline__ unsigned f2bf(float f) { unsigned u = __builtin_bit_cast(unsigned, f); return (u + 0x7fffu + ((u >> 16) & 1u)) >> 16; }
__device__ __forceinline__ unsigned pk2(float lo, float hi) { return f2bf(lo) | (f2bf(hi) << 16); }
__device__ __forceinline__ float bf2f(unsigned short b) { return __builtin_bit_cast(float, (unsigned)b << 16); }
__device__ __forceinline__ void st_bf16x8_nt(bf16_t* p, f32x4 v0, f32x4 v1) {
    u32x4 w; w.x = cvt_pk_bf16(v0[0], v0[1]); w.y = cvt_pk_bf16(v0[2], v0[3]); w.z = cvt_pk_bf16(v1[0], v1[1]); w.w = cvt_pk_bf16(v1[2], v1[3]);
    __builtin_nontemporal_store(w, (u32x4*)p);
}
__device__ __forceinline__ void st_bf16x8(bf16_t* p, f32x4 v0, f32x4 v1) {
    u32x4 w; w.x = cvt_pk_bf16(v0[0], v0[1]); w.y = cvt_pk_bf16(v0[2], v0[3]); w.z = cvt_pk_bf16(v1[0], v1[1]); w.w = cvt_pk_bf16(v1[2], v1[3]);
    *(u32x4*)p = w;
}
__device__ __forceinline__ float wave_sum(float v) {
#pragma unroll
    for (int o = 1; o < 64; o <<= 1) v += __shfl_xor(v, o);
    return v;
}
__device__ __forceinline__ float fexp2(float x) { return __builtin_amdgcn_exp2f(x); }
__device__ __forceinline__ int remap8(int L, int nwg) {
    const int q = nwg / 8, r = nwg % 8, xcd = L % 8, off = L / 8;
    return (xcd < r ? xcd * (q + 1) : r * (q + 1) + (xcd - r) * q) + off;
}
__device__ __forceinline__ void tile_of(int L, int nM, int nN, int& pm, int& pn) {
    const int wgid = remap8(L, nM * nN);
    const int nig = 8 * nN, gid = wgid / nig, fm = gid * 8, gsz = (nM - fm) < 8 ? (nM - fm) : 8;
    pm = fm + ((wgid % nig) % gsz); pn = (wgid % nig) / gsz;
}

namespace pg {
constexpr int BM = 256, BK = 64, HALF = 128, HTB = HALF * BK * 2, STAGE_BYTES = 8 * HTB;
__device__ __forceinline__ int lds_byte(int r, int c) { const int st = (r >> 4) * 2 + (c >> 5), rr = r & 15, cc = c & 31, ob = rr * 64 + cc * 2; return st * 1024 + (ob ^ (((ob >> 9) & 1) << 5)); }
__device__ __forceinline__ void stage_rc(int b, int& R, int& C) { const int st = b / 1024, sb = b % 1024, swz = sb ^ (((sb >> 9) & 1) << 5); R = (st >> 1) * 16 + swz / 64; C = (st & 1) * 32 + (swz % 64) / 2; }
__device__ __forceinline__ int perm32(int rho) { const int n = rho >> 4, i = rho & 15; return 8 * (i >> 2) + 4 * n + (i & 3); }

struct Unit { const char* a; const char* b; const char* a2; const char* b2; int kind, pm, pn, x; };
struct Cfg { int lda, ldb, nt, nt1; };

template <class Epi, class Sched>
__device__ __forceinline__ void gemm_phase(LAS unsigned char* lds, const int tid, const Cfg g, const Sched& S, const Epi& E) {
    const int wid = __builtin_amdgcn_readfirstlane(tid >> 6), lane = tid & 63, wr = wid >> 2, wc = wid & 3, fr = lane & 15, fq = lane >> 4;
    const int nt = g.nt, nt1 = g.nt1;
    unsigned voffA[2], voffB[2];
#pragma unroll
    for (int i = 0; i < 2; ++i) { int R, C; stage_rc(tid * 16 + i * 8192, R, C); const int Rb = (R & ~31) + perm32(R & 31);
        voffA[i] = (unsigned)(R * g.lda + C) * 2u; voffB[i] = (unsigned)(Rb * g.ldb + C) * 2u; }
    const size_t kstep = (size_t)(BK * 2);
    const size_t hstepA = (size_t)HALF * g.lda * 2, hstepB = (size_t)HALF * g.ldb * 2;
    const unsigned ldsw = (unsigned)wid * 1024u;
    const int aoff = lds_byte(wr * 64 + fr, fq * 8), boff = lds_byte(wc * 32 + fr, fq * 8);
#define PG8_SA(b, h) (((b) * 2 + (h)) * HTB)
#define PG8_SB(b, h) ((4 + (b) * 2 + (h)) * HTB)
#define PG8_STAGE(bufoff, gbase, voff) do { _Pragma("unroll") for (int _i = 0; _i < 2; ++_i) \
        __builtin_amdgcn_global_load_lds((const unsigned*)((const char*)(gbase) + (voff)[_i]), (LAS unsigned*)(lds + (bufoff) + ldsw + _i * 8192), 16, 0, 0); } while (0)
#define PG8_LDA(dst, b, h) do { _Pragma("unroll") for (int m = 0; m < 4; ++m) _Pragma("unroll") for (int k = 0; k < 2; ++k) dst[m][k] = *(const LAS bf16x8*)(lds + PG8_SA(b, h) + aoff + m * 2048 + k * 1024); } while (0)
#define PG8_LDB(dst, b, h) do { _Pragma("unroll") for (int n = 0; n < 2; ++n) _Pragma("unroll") for (int k = 0; k < 2; ++k) dst[n][k] = *(const LAS bf16x8*)(lds + PG8_SB(b, h) + boff + n * 2048 + k * 1024); } while (0)
#define PG8_MMA(ai, bj, At, Bt) do { __builtin_amdgcn_s_setprio(1); _Pragma("unroll") for (int m = 0; m < 4; ++m) _Pragma("unroll") for (int n = 0; n < 2; ++n) _Pragma("unroll") for (int k = 0; k < 2; ++k) \
        acc[ai][bj][m][n] = __builtin_amdgcn_mfma_f32_16x16x32_bf16(Bt[n][k], At[m][k], acc[ai][bj][m][n], 0, 0, 0); __builtin_amdgcn_s_setprio(0); } while (0)
#define PG8_WAIT_V(n) asm volatile("s_waitcnt vmcnt(" #n ")" ::: "memory")
#define PG8_WAIT_L(n) asm volatile("s_waitcnt lgkmcnt(" #n ")" ::: "memory")
#define PG8_BAR __builtin_amdgcn_s_barrier()
#define PG8_SCHED __builtin_amdgcn_sched_barrier(0)
#define PG8_KA(u, kt) ((kt) < nt1 ? (u).a + (size_t)(kt) * kstep : (u).a2 + (size_t)((kt) - nt1) * kstep)
#define PG8_KB(u, kt) ((kt) < nt1 ? (u).b + (size_t)(kt) * kstep : (u).b2 + (size_t)((kt) - nt1) * kstep)
    Unit cur, nxt; int ui = 0;
    if (!S.next(0, cur)) return;
    f32x4 acc[2][2][4][2];
#pragma unroll
    for (int a = 0; a < 2; ++a)
#pragma unroll
        for (int b = 0; b < 2; ++b)
#pragma unroll
            for (int m = 0; m < 4; ++m)
#pragma unroll
                for (int n = 0; n < 2; ++n) acc[a][b][m][n] = (f32x4){0.f, 0.f, 0.f, 0.f};
    bf16x8 At[4][2], B0[2][2], B1[2][2];
    if constexpr (Epi::HOOK) { const f32x4 hv = E.hook_load(cur, tid); E.hook_store(lds + STAGE_BYTES, hv, tid); }
    {
        const char* cA = cur.a; const char* cB = cur.b;
        PG8_STAGE(PG8_SB(0, 0), cB, voffB); PG8_STAGE(PG8_SB(0, 1), cB + hstepB, voffB); PG8_STAGE(PG8_SA(0, 0), cA, voffA); PG8_STAGE(PG8_SA(0, 1), cA + hstepA, voffA);
        if (wr == 1) PG8_BAR;
        PG8_WAIT_V(2); PG8_BAR;
        PG8_STAGE(PG8_SB(1, 0), cB + kstep, voffB); PG8_STAGE(PG8_SA(1, 0), cA + kstep, voffA); PG8_STAGE(PG8_SB(1, 1), cB + hstepB + kstep, voffB);
        PG8_WAIT_V(6); PG8_BAR;
    }
    for (;;) {
        const bool has_next = S.next(ui + 1, nxt);
        if (!has_next) nxt = cur;
#pragma nounroll
        for (int t = 0; t < nt; t += 2) {
            const bool last = (t == nt - 2);
            const char* a1 = PG8_KA(cur, t + 1);
            const char* a2 = last ? nxt.a : PG8_KA(cur, t + 2); const char* b2 = last ? nxt.b : PG8_KB(cur, t + 2);
            const char* a3 = last ? nxt.a + kstep : PG8_KA(cur, t + 3); const char* b3 = last ? nxt.b + kstep : PG8_KB(cur, t + 3);
            PG8_LDB(B0, 0, 0); PG8_LDB(B1, 0, 1); PG8_SCHED; PG8_LDA(At, 0, 0); PG8_STAGE(PG8_SA(1, 1), a1 + hstepA, voffA);
            PG8_WAIT_V(8); PG8_WAIT_L(0); PG8_BAR; PG8_MMA(0, 0, At, B0); PG8_MMA(0, 1, At, B1); PG8_BAR; PG8_SCHED;
            PG8_LDA(At, 0, 1); PG8_STAGE(PG8_SB(0, 0), b2, voffB); PG8_STAGE(PG8_SB(0, 1), b2 + hstepB, voffB); PG8_STAGE(PG8_SA(0, 0), a2, voffA);
            PG8_WAIT_V(8); PG8_WAIT_L(0); PG8_BAR; PG8_MMA(1, 0, At, B0); PG8_MMA(1, 1, At, B1); PG8_BAR; PG8_SCHED;
            PG8_LDB(B0, 1, 0); PG8_LDB(B1, 1, 1); PG8_SCHED; PG8_LDA(At, 1, 0); PG8_STAGE(PG8_SA(0, 1), a2 + hstepA, voffA);
            PG8_WAIT_V(8); PG8_WAIT_L(0); PG8_BAR; PG8_MMA(0, 0, At, B0); PG8_MMA(0, 1, At, B1); PG8_BAR; PG8_SCHED;
            PG8_LDA(At, 1, 1); PG8_STAGE(PG8_SB(1, 0), b3, voffB); PG8_STAGE(PG8_SB(1, 1), b3 + hstepB, voffB); PG8_STAGE(PG8_SA(1, 0), a3, voffA);
            PG8_WAIT_V(8); PG8_WAIT_L(0); PG8_BAR; PG8_MMA(1, 0, At, B0); PG8_MMA(1, 1, At, B1); PG8_BAR; PG8_SCHED;
            if constexpr (Epi::HOOK) { if (((t + 2) & 7) == 0) { int tl = tid; asm volatile("" : "+v"(tl)); E.hook(acc, lds + STAGE_BYTES + (ui & 1) * 8192, ((t + 2) >> 3) - 1, wr, tl & 15); PG8_SCHED; } }
        }
        if (wr == 0) PG8_BAR;
        if constexpr (Epi::HOOK) {
            int tl = tid; asm volatile("" : "+v"(tl));
            const f32x4 hv = E.hook_load(nxt, tl);
            E(acc, cur, wr, wc, tl & 15, (tl & 63) >> 4);
            E.hook_store(lds + STAGE_BYTES + ((ui + 1) & 1) * 8192, hv, tl);
        } else
        { int tl = tid; asm volatile("" : "+v"(tl)); E(acc, cur, wr, wc, tl & 15, (tl & 63) >> 4); }
        if (!has_next) break;
#pragma unroll
        for (int a = 0; a < 2; ++a)
#pragma unroll
            for (int b = 0; b < 2; ++b)
#pragma unroll
                for (int m = 0; m < 4; ++m)
#pragma unroll
                    for (int n = 0; n < 2; ++n) acc[a][b][m][n] = (f32x4){0.f, 0.f, 0.f, 0.f};
        cur = nxt; ++ui;
        if (wr == 1) PG8_BAR;
    }
    PG8_WAIT_V(0);
    PG8_BAR;
#undef PG8_SA
#undef PG8_SB
#undef PG8_STAGE
#undef PG8_LDA
#undef PG8_LDB
#undef PG8_MMA
#undef PG8_WAIT_V
#undef PG8_WAIT_L
#undef PG8_BAR
#undef PG8_SCHED
#undef PG8_KA
#undef PG8_KB
}
}
using pg::Unit;

#define EPI_ROWS(...) _Pragma("unroll") for (int ai = 0; ai < 2; ++ai) _Pragma("unroll") for (int m = 0; m < 4; ++m) { const int row = ai * 128 + wr * 64 + m * 16 + fr + zz; __VA_ARGS__; asm volatile("" ::: "memory"); }
typedef f32x4 Acc[2][2][4][2];

struct SchedPlain {
    const char* A; const char* B; int nM, nN; size_t astep, bstep; int G, c;
    __device__ __forceinline__ bool next(int i, Unit& u) const {
        const long L = (long)i * G + c; if (L >= (long)nM * nN) return false;
        int pm, pn; tile_of((int)L, nM, nN, pm, pn);
        u.a = A + (size_t)pm * astep; u.b = B + (size_t)pn * bstep; u.a2 = u.a; u.b2 = u.b; u.kind = 0; u.pm = pm; u.pn = pn; u.x = 0; return true;
    }
};
template <bool F32BASE> struct EpiResT {
    static constexpr bool HOOK = false;
    const float* basef; bf16_t* HB; float* PS; int ps_on;
    __device__ __forceinline__ void operator()(const Acc& acc, const Unit& u, int wr, int wc, int fr, int fq) const {
        int zz = 0; asm volatile("" : "+v"(zz));
        EPI_ROWS(
            float ss = 0.f;
            _Pragma("unroll") for (int bj = 0; bj < 2; ++bj) {
                const size_t p = (size_t)(u.pm * 256 + row) * DM + u.pn * 256 + bj * 128 + wc * 32 + fq * 8;
                f32x4 b0, b1;
                if (F32BASE) { b0 = *(const f32x4*)(basef + p); b1 = *(const f32x4*)(basef + p + 4); }
                else { const u32x4 hv = *(const u32x4*)(HB + p);
                    b0[0] = __builtin_bit_cast(float, hv.x << 16); b0[1] = __builtin_bit_cast(float, hv.x & 0xffff0000u); b0[2] = __builtin_bit_cast(float, hv.y << 16); b0[3] = __builtin_bit_cast(float, hv.y & 0xffff0000u);
                    b1[0] = __builtin_bit_cast(float, hv.z << 16); b1[1] = __builtin_bit_cast(float, hv.z & 0xffff0000u); b1[2] = __builtin_bit_cast(float, hv.w << 16); b1[3] = __builtin_bit_cast(float, hv.w & 0xffff0000u); }
                const f32x4 v0 = b0 + acc[ai][bj][m][0], v1 = b1 + acc[ai][bj][m][1];
                st_bf16x8(HB + p, v0, v1);
                ss += (v0[0] * v0[0] + v0[1] * v0[1]) + (v0[2] * v0[2] + v0[3] * v0[3]) + (v1[0] * v1[0] + v1[1] * v1[1]) + (v1[2] * v1[2] + v1[3] * v1[3]); }
            if (ps_on) { ss += __shfl_xor(ss, 16); ss += __shfl_xor(ss, 32); if (fq == 0) PS[(size_t)(u.pm * 256 + row) * 32 + u.pn * 4 + wc] = ss; })
    }
};
typedef EpiResT<false> EpiRes;
struct EpiResHook : EpiRes {
    static constexpr bool HOOK = true;
    const float* RAT;
    __device__ __forceinline__ f32x4 hook_load(const Unit& u, int tid) const { return *(const f32x4*)(RAT + (size_t)u.pm * 2048 + tid * 4); }
    __device__ __forceinline__ void hook_store(LAS unsigned char* lx, f32x4 v, int tid) const { *(LAS f32x4*)(lx + tid * 16) = v; }
    __device__ __forceinline__ void hook(Acc& acc, LAS const unsigned char* lx, int hk, int wr, int fr) const {
#pragma unroll
        for (int ai = 0; ai < 2; ++ai)
#pragma unroll
            for (int m = 0; m < 4; ++m) {
                const float rt = *(LAS const float*)(lx + ((ai * 128 + wr * 64 + m * 16 + fr) * 8 + hk) * 4);
#pragma unroll
                for (int bj = 0; bj < 2; ++bj)
#pragma unroll
                    for (int n = 0; n < 2; ++n) acc[ai][bj][m][n] *= rt;
            }
    }
};
struct EpiUp {
    static constexpr bool HOOK = false;
    bf16_t* U; const float* PS;
    __device__ __forceinline__ void operator()(const Acc& acc, const Unit& u, int wr, int wc, int fr, int fq) const {
        int zz = 0; asm volatile("" : "+v"(zz));
        EPI_ROWS(
            float rs;
            { const f32x4 pa = *(const f32x4*)(PS + (size_t)(u.pm * 256 + row) * 32 + fq * 8), pb = *(const f32x4*)(PS + (size_t)(u.pm * 256 + row) * 32 + fq * 8 + 4);
              float tot = ((pa.x + pa.y) + (pa.z + pa.w)) + ((pb.x + pb.y) + (pb.z + pb.w));
              tot += __shfl_xor(tot, 16); tot += __shfl_xor(tot, 32);
              rs = 1.f / sqrtf(tot * (1.f / DM) + RMS_EPS); }
            _Pragma("unroll") for (int bj = 0; bj < 2; ++bj) {
                f32x4 v0 = acc[ai][bj][m][0] * rs, v1 = acc[ai][bj][m][1] * rs;
                _Pragma("unroll") for (int e = 0; e < 4; ++e) { const float a = fmaxf(v0[e], 0.f), b = fmaxf(v1[e], 0.f); v0[e] = a * a; v1[e] = b * b; }
                st_bf16x8_nt(U + (size_t)(u.pm * 256 + row) * DFF + u.pn * 256 + bj * 128 + wc * 32 + fq * 8, v0, v1); })
    }
};

struct SchedF1 {
    const char* XN; const char* Wqkf; const char* Wv; int G, c;
    __device__ __forceinline__ bool next(int i, Unit& u) const {
        long L = (long)i * G + c; int pm, pn;
        if (L < 64 * 16) { tile_of((int)L, 64, 16, pm, pn); u.a = XN + (size_t)pm * 256 * DM * 2; u.b = Wqkf + (size_t)pn * 256 * DM * 2; u.kind = pn < 8 ? 0 : 1; }
        else { L -= 64 * 16; if (L >= 8 * 64) return false; tile_of((int)L, 8, 64, pm, pn); u.a = Wv + (size_t)pm * 256 * DM * 2; u.b = XN + (size_t)pn * 256 * DM * 2; u.kind = 3; }
        u.a2 = u.a; u.b2 = u.b; u.pm = pm; u.pn = pn; u.x = 0; return true;
    }
};
struct EpiF1 {
    static constexpr bool HOOK = false;
    bf16_t* Q; bf16_t* K; bf16_t* VT; float* LF; const float* bfv; float qscale; const float* RS;
    __device__ __forceinline__ void operator()(const Acc& acc, const Unit& u, int wr, int wc, int fr, int fq) const {
        int zz = 0; asm volatile("" : "+v"(zz));
        bf16_t* base; size_t ld; float sc = 1.f;
        if (u.kind == 0) { base = Q + (size_t)u.pm * 256 * DM + u.pn * 256; ld = DM; sc = qscale; }
        else if (u.kind == 1) { base = K + (size_t)u.pm * 256 * DM + (u.pn - 8) * 256; ld = DM; }
        else { base = VT + (size_t)u.pm * 256 * MTOK + u.pn * 256; ld = MTOK; }
        if (u.kind == 3) {
            f32x4 cs[2][2];
            _Pragma("unroll") for (int bj = 0; bj < 2; ++bj) _Pragma("unroll") for (int nn = 0; nn < 2; ++nn) cs[bj][nn] = *(const f32x4*)(RS + u.pn * 256 + bj * 128 + wc * 32 + fq * 8 + nn * 4 + zz);
            EPI_ROWS(
                _Pragma("unroll") for (int bj = 0; bj < 2; ++bj)
                    st_bf16x8(base + (size_t)row * ld + bj * 128 + wc * 32 + fq * 8, acc[ai][bj][m][0] * cs[bj][0], acc[ai][bj][m][1] * cs[bj][1]);)
            return;
        }
        EPI_ROWS(
            const float rs = RS[u.pm * 256 + row] * sc;
            _Pragma("unroll") for (int bj = 0; bj < 2; ++bj)
                st_bf16x8(base + (size_t)row * ld + bj * 128 + wc * 32 + fq * 8, acc[ai][bj][m][0] * rs, acc[ai][bj][m][1] * rs);)
    }
};

__device__ __forceinline__ float ret_lg2(int h) { return log2f(1.f - exp2f(-5.f - (float)h)); }
struct SchedR1 {
    const char* XNh; const char* Wqkg; const char* Wv; int G, c;
    __device__ __forceinline__ bool next(int i, Unit& u) const {
        long L = (long)i * G + c; int pm, pn;
        if (L < 32 * 32) { tile_of((int)L, 32, 32, pm, pn); u.a = XNh + (size_t)pm * 256 * DM * 2; u.b = Wqkg + (size_t)pn * 256 * DM * 2; u.kind = pn < 8 ? 0 : (pn < 16 ? 1 : 2); }
        else { L -= 32 * 32; if (L >= 16 * 32) return false; tile_of((int)L, 16, 32, pm, pn); u.a = Wv + (size_t)pm * 256 * DM * 2; u.b = XNh + (size_t)pn * 256 * DM * 2; u.kind = 3; }
        u.a2 = u.a; u.b2 = u.b; u.pm = pm; u.pn = pn; u.x = 0; return true;
    }
};
struct EpiR1 {
    static constexpr bool HOOK = false;
    bf16_t* QR; bf16_t* KR; bf16_t* KT; bf16_t* Gt; bf16_t* VDT; const float* cosT; const float* sinT; int hb; const float* RS;
    __device__ __forceinline__ void operator()(const Acc& acc, const Unit& u, int wr, int wc, int fr, int fq) const {
        int zz = 0; asm volatile("" : "+v"(zz));
        if (u.kind <= 1) {
            const int h = u.pn & 7, bl = u.pm >> 4, n = u.pm & 15, bhl = bl * 8 + h;
            bf16_t* dst = (u.kind == 0 ? QR : KR) + ((size_t)bhl * SEQ + n * 256) * 256;
            bf16_t* dstT = KT + (size_t)(bhl * 16 + n) * 65536;
            const float sc = u.kind == 0 ? 1.f : 0.0625f;
            const int j0 = wc * 32 + fq * 8;
            EPI_ROWS(
                const int s = n * 256 + row;
                const float rs = RS[hb * 8192 + u.pm * 256 + row] * sc;
                _Pragma("unroll") for (int nn = 0; nn < 2; ++nn) {
                    const f32x4 cs = *(const f32x4*)(cosT + (size_t)s * 128 + j0 + nn * 4), sn = *(const f32x4*)(sinT + (size_t)s * 128 + j0 + nn * 4);
                    const f32x4 x1 = acc[ai][0][m][nn], x2 = acc[ai][1][m][nn];
                    const f32x4 o1 = (x1 * cs - x2 * sn) * rs, o2 = (x1 * sn + x2 * cs) * rs;
                    u32x2 w1, w2; w1.x = cvt_pk_bf16(o1[0], o1[1]); w1.y = cvt_pk_bf16(o1[2], o1[3]); w2.x = cvt_pk_bf16(o2[0], o2[1]); w2.y = cvt_pk_bf16(o2[2], o2[3]);
                    *(u32x2*)(dst + (size_t)row * 256 + j0 + nn * 4) = w1; *(u32x2*)(dst + (size_t)row * 256 + 128 + j0 + nn * 4) = w2;
                    if (u.kind == 1) {
                        _Pragma("unroll") for (int e = 0; e < 4; ++e) {
                            const unsigned a = e < 2 ? w1.x : w1.y, b = e < 2 ? w2.x : w2.y;
                            dstT[(size_t)(j0 + nn * 4 + e) * 256 + row] = (bf16_t)((e & 1) ? (a >> 16) : (a & 0xffffu));
                            dstT[(size_t)(128 + j0 + nn * 4 + e) * 256 + row] = (bf16_t)((e & 1) ? (b >> 16) : (b & 0xffffu)); }
                    } })
        } else if (u.kind == 2) {
            bf16_t* base = Gt + ((size_t)hb * 8192 + u.pm * 256) * 4096 + (u.pn - 16) * 256;
            EPI_ROWS(
                const float rs = RS[hb * 8192 + u.pm * 256 + row];
                _Pragma("unroll") for (int bj = 0; bj < 2; ++bj) {
                    f32x4 v0 = acc[ai][bj][m][0] * rs, v1 = acc[ai][bj][m][1] * rs;
                    _Pragma("unroll") for (int e = 0; e < 4; ++e) { v0[e] = v0[e] * __builtin_amdgcn_rcpf(1.f + fexp2(-v0[e] * LOG2E)); v1[e] = v1[e] * __builtin_amdgcn_rcpf(1.f + fexp2(-v1[e] * LOG2E)); }
                    st_bf16x8(base + (size_t)row * 4096 + bj * 128 + wc * 32 + fq * 8, v0, v1); })
        } else {
            const int h = u.pm >> 1, et = u.pm & 1, bl = u.pn >> 4, n = u.pn & 15, bhl = bl * 8 + h;
            const float lg = ret_lg2(h);
            bf16_t* base = VDT + ((size_t)(bhl * 16 + n) * 512 + et * 256) * 256;
            f32x4 dk[2][2];
            _Pragma("unroll") for (int bj = 0; bj < 2; ++bj) _Pragma("unroll") for (int nn = 0; nn < 2; ++nn) _Pragma("unroll") for (int e = 0; e < 4; ++e)
                dk[bj][nn][e] = fexp2((float)(255 - (bj * 128 + wc * 32 + fq * 8 + nn * 4 + e)) * lg) * RS[hb * 8192 + u.pn * 256 + bj * 128 + wc * 32 + fq * 8 + nn * 4 + e + zz];
            EPI_ROWS(
                _Pragma("unroll") for (int bj = 0; bj < 2; ++bj)
                    st_bf16x8(base + (size_t)row * 256 + bj * 128 + wc * 32 + fq * 8, acc[ai][bj][m][0] * dk[bj][0], acc[ai][bj][m][1] * dk[bj][1]);)
        }
    }
};

struct SchedR2 {
    const char* QR; const char* KR; const char* KT; const char* VDT; int G, c;
    __device__ __forceinline__ bool next(int i, Unit& u) const {
        long L = (long)i * G + c;
        if (L < 256) { const int id = remap8((int)L, 256); u.pm = id >> 4; u.pn = id & 15; u.kind = 0; u.x = 0;
            u.a = QR + ((size_t)u.pm * SEQ + u.pn * 256) * 512; u.b = KR + ((size_t)u.pm * SEQ + u.pn * 256) * 512; }
        else { L -= 256; if (L >= 480) return false; const int id = remap8((int)L, 480); const int bhl = id / 30, rem = id % 30; u.pm = bhl; u.pn = rem >> 1; u.x = rem & 1; u.kind = 1;
            u.a = VDT + ((size_t)(bhl * 16 + u.pn) * 512 + u.x * 256) * 512; u.b = KT + (size_t)(bhl * 16 + u.pn) * 131072; }
        u.a2 = u.a; u.b2 = u.b; return true;
    }
};
struct EpiR2 {
    static constexpr bool HOOK = false;
    bf16_t* KR; bf16_t* ST;
    __device__ __forceinline__ void operator()(const Acc& acc, const Unit& u, int wr, int wc, int fr, int fq) const {
        int zz = 0; asm volatile("" : "+v"(zz));
        if (u.kind == 0) {
            const float sc = fexp2(-256.f * ret_lg2(u.pm & 7));
            bf16_t* base = KR + ((size_t)u.pm * SEQ + u.pn * 256) * 256;
            EPI_ROWS(
                _Pragma("unroll") for (int bj = 0; bj < 2; ++bj) {
                    const int c0 = bj * 128 + wc * 32 + fq * 8; f32x4 v0, v1;
                    _Pragma("unroll") for (int e = 0; e < 4; ++e) { v0[e] = (c0 + e <= row) ? acc[ai][bj][m][0][e] * sc : 0.f; v1[e] = (c0 + 4 + e <= row) ? acc[ai][bj][m][1][e] * sc : 0.f; }
                    st_bf16x8(base + (size_t)row * 256 + c0, v0, v1); })
        } else {
            bf16_t* base = ST + ((size_t)(u.pm * 17 + u.pn + 1) * 512 + u.x * 256) * 256;
            EPI_ROWS(
                _Pragma("unroll") for (int bj = 0; bj < 2; ++bj)
                    st_bf16x8(base + (size_t)row * 256 + bj * 128 + wc * 32 + fq * 8, acc[ai][bj][m][0], acc[ai][bj][m][1]);)
        }
    }
};

struct SchedR4 {
    const char* P; const char* QR; const char* VDT; const char* ST; int G, c;
    __device__ __forceinline__ bool next(int i, Unit& u) const {
        const long L = (long)i * G + c; if (L >= 512) return false;
        const int id = remap8((int)L, 512); const int bhl = id >> 5, n = (id >> 1) & 15, et = id & 1;
        u.pm = bhl; u.pn = n; u.x = et; u.kind = 0;
        u.a = P + ((size_t)bhl * SEQ + n * 256) * 512; u.a2 = QR + ((size_t)bhl * SEQ + n * 256) * 512;
        u.b = VDT + ((size_t)(bhl * 16 + n) * 512 + et * 256) * 512; u.b2 = ST + ((size_t)(bhl * 17 + n) * 512 + et * 256) * 512;
        return true;
    }
};
struct EpiR4 {
    static constexpr bool HOOK = false;
    bf16_t* Gt; float* SS; const float* gn; int hb;
    __device__ __forceinline__ void operator()(const Acc& acc, const Unit& u, int wr, int wc, int fr, int fq) const {
        int zz = 0; asm volatile("" : "+v"(zz));
        const int h = u.pm & 7, bl = u.pm >> 3, et = u.x;
        const float lg = ret_lg2(h);
        const size_t tok0 = (size_t)hb * 8192 + bl * SEQ + u.pn * 256;
        const int cbase = h * 512 + et * 256;
        EPI_ROWS(
            const float qd = fexp2((float)(row + 1) * lg);
            float ss = 0.f;
            _Pragma("unroll") for (int bj = 0; bj < 2; ++bj) {
                const int c0 = cbase + bj * 128 + wc * 32 + fq * 8;
                bf16_t* gp = Gt + (tok0 + row) * 4096 + c0;
                const u32x4 gv = *(const u32x4*)gp;
                const f32x4 g0 = *(const f32x4*)(gn + c0), g1 = *(const f32x4*)(gn + c0 + 4);
                f32x4 v0 = acc[ai][bj][m][0] * qd, v1 = acc[ai][bj][m][1] * qd;
                ss += (v0[0] * v0[0] + v0[1] * v0[1]) + (v0[2] * v0[2] + v0[3] * v0[3]) + (v1[0] * v1[0] + v1[1] * v1[1]) + (v1[2] * v1[2] + v1[3] * v1[3]);
                f32x4 t0, t1;
                t0[0] = __builtin_bit_cast(float, gv.x << 16); t0[1] = __builtin_bit_cast(float, gv.x & 0xffff0000u); t0[2] = __builtin_bit_cast(float, gv.y << 16); t0[3] = __builtin_bit_cast(float, gv.y & 0xffff0000u);
                t1[0] = __builtin_bit_cast(float, gv.z << 16); t1[1] = __builtin_bit_cast(float, gv.z & 0xffff0000u); t1[2] = __builtin_bit_cast(float, gv.w << 16); t1[3] = __builtin_bit_cast(float, gv.w & 0xffff0000u);
                st_bf16x8(gp, v0 * g0 * t0, v1 * g1 * t1); }
            ss += __shfl_xor(ss, 16); ss += __shfl_xor(ss, 32);
            if (fq == 0) SS[((tok0 + row) * 8 + h) * 8 + et * 4 + wc] = ss;)
    }
};

constexpr int AT_KP = 272, AT_VP = 144, AT_KBUF = 64 * AT_KP, AT_VBUF = 128 * AT_VP, AT_VOFF = 2 * AT_KBUF, AT_COFF = AT_VOFF + 3 * AT_VBUF, AT_QOFF = AT_COFF + 512;
constexpr int AT_LDS_END = AT_QOFF + 8 * 5120;
__device__ __forceinline__ int crow(int r, int hi) { return (r & 3) + 8 * (r >> 2) + 4 * hi; }
constexpr float AT_THR = 8.f;
__device__ __forceinline__ float at_max3(float a, float b, float c) { float r; asm("v_max3_f32 %0, %1, %2, %3" : "=v"(r) : "v"(a), "v"(b), "v"(c)); return r; }
#define AT_MFMA(a, b, c) __builtin_amdgcn_mfma_f32_32x32x16_bf16((a), (b), (c), 0, 0, 0)
typedef float at_f32x2 __attribute__((ext_vector_type(2))); typedef __bf16 at_bf16x2 __attribute__((ext_vector_type(2)));
__device__ __forceinline__ unsigned at_cvt_pk(float lo, float hi) { at_f32x2 v = {lo, hi}; at_bf16x2 b = __builtin_convertvector(v, at_bf16x2); return __builtin_bit_cast(unsigned, b); }
#define AT_FRAG_LD(A0, A1, QF, Kb, Qb, ks) do { A0 = *(LAS const bf16x8*)((Kb) + (ks) * 32); A1 = *(LAS const bf16x8*)((Kb) + 32 * AT_KP + (ks) * 32); \
        if ((ks) >= 3) QF = *(LAS const bf16x8*)((Qb) + ((((ks) - 3) * 2 + hh) << 4)); } while (0)
#define AT_QSEL(QF, ks) (((ks) < 3) ? qreg[(ks) < 3 ? (ks) : 0] : (QF))
#define AT_SB() __builtin_amdgcn_sched_barrier(0)
#define AT_EXP_STEP(S0, S1, ks) do { S0[2 * (ks)] = fexp2(S0[2 * (ks)]); S0[2 * (ks) + 1] = fexp2(S0[2 * (ks) + 1]); S1[2 * (ks)] = fexp2(S1[2 * (ks)]); S1[2 * (ks) + 1] = fexp2(S1[2 * (ks) + 1]); \
        ls += (S0[2 * (ks)] + S0[2 * (ks) + 1]) + (S1[2 * (ks)] + S1[2 * (ks) + 1]); \
        pw[(ks) >> 2][(ks) & 3] = at_cvt_pk(S0[2 * (ks)], S0[2 * (ks) + 1]); pw[2 + ((ks) >> 2)][(ks) & 3] = at_cvt_pk(S1[2 * (ks)], S1[2 * (ks) + 1]); } while (0)
#define AT_BIAS_G(S0, S1, cbuf, g) do { LAS const float* cb_ = (LAS const float*)(lds + AT_COFF + (cbuf) * 256) + hh * 4; \
        const f32x4 c0 = *(LAS const f32x4*)(cb_ + 8 * (g)), c1 = *(LAS const f32x4*)(cb_ + 32 + 8 * (g)); \
        _Pragma("unroll") for (int e = 0; e < 4; ++e) { S0[4 * (g) + e] -= c0[e]; S1[4 * (g) + e] -= c1[e]; } } while (0)
#define AT_MASK_MAX(S0, S1, tt, jbb, MX) do { \
        if ((jbb) >= 0) { const int kv0 = 64 * (tt) + 4 * hh; \
            _Pragma("unroll") for (int i = 0; i < 16; ++i) { const int kv = kv0 + (i & 3) + 8 * (i >> 2); if (kv > q_row) S0[i] = -INFINITY; if (kv + 32 > q_row) S1[i] = -INFINITY; } } \
        float mx_ = at_max3(S0[0], S0[1], S1[0]), my_ = at_max3(S0[2], S0[3], S1[1]); mx_ = at_max3(mx_, S1[2], S1[3]); \
        _Pragma("unroll") for (int i = 4; i < 16; i += 4) { mx_ = at_max3(mx_, S0[i], S0[i + 1]); my_ = at_max3(my_, S0[i + 2], S0[i + 3]); mx_ = at_max3(mx_, S1[i], S1[i + 1]); my_ = at_max3(my_, S1[i + 2], S1[i + 3]); } \
        mx_ = fmaxf(mx_, my_); MX = fmaxf(mx_, __shfl_xor(mx_, 32)); } while (0)
#define AT_BIAS_MAX(S0, S1, cbuf, tt, jbb, MX) do { _Pragma("unroll") for (int g_ = 0; g_ < 4; ++g_) AT_BIAS_G(S0, S1, cbuf, g_); AT_MASK_MAX(S0, S1, tt, jbb, MX); } while (0)
__device__ __forceinline__ void attn_unit(LAS unsigned char* lds, const int tid_in, int bh, int qb, const bf16_t* __restrict__ Q, const bf16_t* __restrict__ K, const bf16_t* __restrict__ VT, const float* __restrict__ c2, bf16_t* __restrict__ O) {
    int tid = tid_in; asm volatile("" : "+v"(tid));
    const int lane = tid & 63, r = lane & 31, hh = lane >> 5;
    const int wid = __builtin_amdgcn_readfirstlane(tid >> 6);
    const int b = bh >> 4, h = bh & 15;
    const int q_row = qb * 256 + wid * 32 + r;
    LAS unsigned char* Qb = lds + AT_QOFF + wid * 5120 + r * 160;
    bf16x8 qreg[3];
    {
        const bf16_t* Qp = Q + ((size_t)(b * SEQ + q_row)) * DM + h * 128 + hh * 8;
#pragma unroll
        for (int ks = 0; ks < 3; ++ks) qreg[ks] = *(const bf16x8*)(Qp + ks * 16);
#pragma unroll
        for (int ks = 3; ks < 8; ++ks) *(LAS bf16x8*)(Qb + (((ks - 3) * 2 + hh) << 4)) = *(const bf16x8*)(Qp + ks * 16);
    }
    const float c2ref = c2[bh * SEQ + qb * 256];
    const int NT = (qb + 1) * 4;
    const int krow = tid >> 4, kch = tid & 15;
    const bf16_t* Ksrc = K + ((size_t)(b * SEQ + krow)) * DM + h * 128 + kch * 8;
    const int kdst = krow * AT_KP + kch * 16;
    const int vrow = tid >> 3, vch = tid & 7;
    const bf16_t* Vsrc = VT + ((size_t)(h * 128 + vrow)) * MTOK + b * SEQ + vch * 8;
    const int vdst = AT_VOFF + vrow * AT_VP + (vch >> 1) * 32 + (vch & 1) * 8;
    const float* csrc = c2 + bh * SEQ + (tid & 63);
    u32x4 kr[2], vr[2]; float cr = 0.f;
#define AT_LOAD(t) do { _Pragma("unroll") for (int i = 0; i < 2; ++i) { kr[i] = *(const u32x4*)(Ksrc + (size_t)(64 * (t) + 32 * i) * DM); vr[i] = *(const u32x4*)(Vsrc + 64 * (t) + (size_t)i * 64 * MTOK); } \
        if (tid < 64) cr = csrc[64 * (t)] - c2ref; } while (0)
#define AT_STORE(kb, vb) do { _Pragma("unroll") for (int i = 0; i < 2; ++i) { *(LAS u32x4*)(lds + (kb) * AT_KBUF + kdst + i * 32 * AT_KP) = kr[i]; \
        *(LAS u32x2*)(lds + (vb) * AT_VBUF + vdst + i * 64 * AT_VP) = (u32x2){vr[i].x, vr[i].y}; *(LAS u32x2*)(lds + (vb) * AT_VBUF + vdst + i * 64 * AT_VP + 16) = (u32x2){vr[i].z, vr[i].w}; } \
        if (tid < 64) *(LAS float*)(lds + AT_COFF + (kb) * 256 + tid * 4) = cr; } while (0)
    f32x16 o[4];
#pragma unroll
    for (int d = 0; d < 4; ++d)
#pragma unroll
        for (int i = 0; i < 16; ++i) o[d][i] = 0.f;
    float mref = 0.f, lrun = 0.f, mxc = 0.f;
    f32x16 sc0, sc1;
    AT_LOAD(0); AT_STORE(0, 0);
    AT_LOAD(1); AT_STORE(1, 1);
    __syncthreads();
    {
        LAS const unsigned char* Kb = lds + r * AT_KP + hh * 16;
#pragma unroll
        for (int i = 0; i < 16; ++i) { sc0[i] = 0.f; sc1[i] = 0.f; }
#pragma unroll
        for (int ks = 0; ks < 8; ++ks) { bf16x8 a0, a1, qf; AT_FRAG_LD(a0, a1, qf, Kb, Qb, ks); sc0 = AT_MFMA(a0, AT_QSEL(qf, ks), sc0); sc1 = AT_MFMA(a1, AT_QSEL(qf, ks), sc1); }
        AT_BIAS_MAX(sc0, sc1, 0, 0, -(NT - 4), mxc);
    }
    __syncthreads();
    int v0 = 0, v1 = 1, v2 = 2;
    for (int t = 0; t < NT; ++t) {
        if (t + 2 < NT) AT_LOAD(t + 2);
        const int wlim = wid >> 1;
        const bool act = (t - (NT - 4)) <= wlim, actn = (t + 1 < NT) && ((t + 1 - (NT - 4)) <= wlim);
        if (act) {
            if (t == 0 || __any(mxc > AT_THR)) {
                const float dl = (t == 0) ? mxc : fmaxf(mxc, 0.f);
                mref += dl;
#pragma unroll
                for (int i = 0; i < 16; ++i) { sc0[i] -= dl; sc1[i] -= dl; }
                if (t != 0) {
                    const float alpha = fexp2(-dl);
                    lrun *= alpha;
#pragma unroll
                    for (int d = 0; d < 4; ++d)
#pragma unroll
                        for (int i = 0; i < 16; ++i) o[d][i] *= alpha;
                }
            }
            f32x16 sn0, sn1; float mxn = 0.f; float ls = 0.f; u32x4 pw[4];
            {
                LAS const unsigned char* Kb = lds + ((t + 1) & 1) * AT_KBUF + r * AT_KP + hh * 16;
                const float nm = -mref;
#pragma unroll
                for (int i = 0; i < 16; ++i) { sn0[i] = nm; sn1[i] = nm; }
                bf16x8 fa0[2], fa1[2], fq[2];
                AT_SB();
                AT_FRAG_LD(fa0[0], fa1[0], fq[0], Kb, Qb, 0);
#pragma unroll
                for (int ks = 0; ks < 8; ++ks) {
                    if (ks < 7) AT_FRAG_LD(fa0[(ks + 1) & 1], fa1[(ks + 1) & 1], fq[(ks + 1) & 1], Kb, Qb, ks + 1);
                    sn0 = AT_MFMA(fa0[ks & 1], AT_QSEL(fq[ks & 1], ks), sn0); sn1 = AT_MFMA(fa1[ks & 1], AT_QSEL(fq[ks & 1], ks), sn1);
                    AT_EXP_STEP(sc0, sc1, ks);
                }
#pragma unroll
                for (int ks = 0; ks < 8; ++ks) {
                    __builtin_amdgcn_sched_group_barrier(0x100, 3, 0);
                    __builtin_amdgcn_sched_group_barrier(0x008, 1, 0);
                    __builtin_amdgcn_sched_group_barrier(0x400, 2, 0);
                    __builtin_amdgcn_sched_group_barrier(0x002, 3, 0);
                    __builtin_amdgcn_sched_group_barrier(0x008, 1, 0);
                    __builtin_amdgcn_sched_group_barrier(0x400, 2, 0);
                    __builtin_amdgcn_sched_group_barrier(0x002, 3, 0);
                }
                AT_SB();
            }
            lrun += ls;
            LAS const unsigned char* Vb = lds + AT_VOFF + v0 * AT_VBUF + r * AT_VP + hh * 16;
            {
                bf16x8 fv[2];
                fv[0] = *(LAS const bf16x8*)(Vb);
                AT_SB();
#pragma unroll
                for (int i = 0; i < 16; ++i) {
                    const int s_ = i >> 2, d_ = i & 3;
                    if (i < 15) { const int sn_ = (i + 1) >> 2, dn_ = (i + 1) & 3; fv[(i + 1) & 1] = *(LAS const bf16x8*)(Vb + dn_ * 32 * AT_VP + sn_ * 32); }
                    o[d_] = AT_MFMA(fv[i & 1], __builtin_bit_cast(bf16x8, pw[s_]), o[d_]);
                    if ((i & 3) == 3) { if (actn) AT_BIAS_G(sn0, sn1, (t + 1) & 1, s_); AT_SB(); }
                }
            }
            if (actn) {
                AT_MASK_MAX(sn0, sn1, t + 1, t + 1 - (NT - 4), mxn);
                sc0 = sn0; sc1 = sn1; mxc = mxn;
            }
        }
        if (t + 2 < NT) AT_STORE(t & 1, v2);
        __syncthreads();
        const int tmp = v0; v0 = v1; v1 = v2; v2 = tmp;
    }
    const float ltot = lrun + __shfl_xor(lrun, 32);
    const float inv = 1.f / ltot;
    bf16_t* Op = O + ((size_t)(b * SEQ + q_row)) * DM + h * 128 + 4 * hh;
#pragma unroll
    for (int d = 0; d < 4; ++d)
#pragma unroll
        for (int g = 0; g < 4; ++g) { u32x2 w; w.x = cvt_pk_bf16(o[d][4 * g] * inv, o[d][4 * g + 1] * inv); w.y = cvt_pk_bf16(o[d][4 * g + 2] * inv, o[d][4 * g + 3] * inv);
            *(u32x2*)(Op + d * 32 + 8 * g) = w; }
#undef AT_LOAD
#undef AT_STORE
}

__device__ __forceinline__ void transpose_load(float (&v)[32], const float* W, int N, int item, int lane) {
    const int nblk = N / 32, kb = item / nblk, nb = item % nblk, k0 = 64 * kb, n0 = 32 * nb;
    const float* p = W + (size_t)(k0 + (lane >> 5)) * N + n0 + (lane & 31);
#pragma unroll
    for (int i = 0; i < 32; ++i) v[i] = p[(size_t)(2 * i) * N];
}
__device__ __forceinline__ void transpose_store(const float (&v)[32], const float* gain, int K, int N, bf16_t* WT, int row_off, LAS float* scr, int item, int lane) {
    const int nblk = N / 32, kb = item / nblk, nb = item % nblk, k0 = 64 * kb, n0 = 32 * nb;
#pragma unroll
    for (int i = 0; i < 32; ++i) scr[(2 * i + (lane >> 5)) * 33 + (lane & 31)] = v[i];
    const int c = lane & 7;
    f32x4 g0 = (f32x4){1.f, 1.f, 1.f, 1.f}, g1 = g0;
    if (gain) { g0 = *(const f32x4*)(gain + k0 + 8 * c); g1 = *(const f32x4*)(gain + k0 + 8 * c + 4); }
    asm volatile("s_waitcnt lgkmcnt(0)" ::: "memory");
#pragma unroll
    for (int j = 0; j < 4; ++j) { const int n = (lane >> 3) + 8 * j; const LAS float* s = scr + (8 * c) * 33 + n;
        u32x4 o; o.x = pk2(s[0 * 33] * g0.x, s[1 * 33] * g0.y); o.y = pk2(s[2 * 33] * g0.z, s[3 * 33] * g0.w); o.z = pk2(s[4 * 33] * g1.x, s[5 * 33] * g1.y); o.w = pk2(s[6 * 33] * g1.z, s[7 * 33] * g1.w);
        *(u32x4*)(WT + (size_t)(row_off + n0 + n) * K + k0 + 8 * c) = o; }
    asm volatile("s_waitcnt lgkmcnt(0)" ::: "memory");
}
__device__ __forceinline__ void transpose_job(const float* W, const float* gain, int K, int N, bf16_t* WT, int row_off, LAS float* scr, int it, int ni, int step, int lane) {
    float va[32], vb[32];
    if (it < ni) transpose_load(va, W, N, it, lane);
    while (it < ni) {
        int nx = it + step;
        if (nx < ni) transpose_load(vb, W, N, nx, lane);
        transpose_store(va, gain, K, N, WT, row_off, scr, it, lane);
        it = nx; if (it >= ni) break;
        nx = it + step;
        if (nx < ni) transpose_load(va, W, N, nx, lane);
        transpose_store(vb, gain, K, N, WT, row_off, scr, it, lane);
        it = nx;
    }
}
__device__ __forceinline__ void rms_rows_bf16(const float* src, const float* g, bf16_t* dst, int gw, int NGW, int lane) {
    for (int mrow = gw; mrow < MTOK; mrow += NGW) {
        const f32x4* xr = (const f32x4*)(src + (size_t)mrow * DM) + lane; f32x4 v[8]; float s = 0.f;
#pragma unroll
        for (int j = 0; j < 8; ++j) { v[j] = xr[64 * j]; s += (v[j].x * v[j].x + v[j].y * v[j].y) + (v[j].z * v[j].z + v[j].w * v[j].w); }
        const float rstd = 1.f / sqrtf(wave_sum(s) * (1.f / DM) + RMS_EPS);
        u32x2* o8 = (u32x2*)(dst + (size_t)mrow * DM) + lane;
#pragma unroll
        for (int j = 0; j < 8; ++j) { const f32x4 gg = ((const f32x4*)g)[lane + 64 * j]; u32x2 w; w.x = cvt_pk_bf16(v[j].x * rstd * gg.x, v[j].y * rstd * gg.y); w.y = cvt_pk_bf16(v[j].z * rstd * gg.z, v[j].w * rstd * gg.w); o8[64 * j] = w; }
    }
}

#define XB_TMO      128
#define XB_XCNT(j)  (256  + 64 * (j))
#define XB_XSUB(j)  (1280 + 64 * (j))
#define XB_XGEN(j)  (2304 + 64 * (j))
#define XB_TOP      3328
#define XB_TOPGEN   3392
#define XCD_BAR_WORDS 3456
#define XB_SPIN_CAP (1u << 18)

__device__ __forceinline__ unsigned xb_ld(unsigned* p)              { return __hip_atomic_load(p, __ATOMIC_RELAXED, __HIP_MEMORY_SCOPE_AGENT); }
__device__ __forceinline__ unsigned xb_add(unsigned* p, unsigned v) { return __hip_atomic_fetch_add(p, v, __ATOMIC_RELAXED, __HIP_MEMORY_SCOPE_AGENT); }
__device__ __forceinline__ unsigned xb_xcc_id() { return (unsigned)__builtin_amdgcn_s_getreg((3 << 11) | 20) & 0xFu; }
#define XB_SPIN(cond, bar) do { unsigned _sp = 0; while (cond) { __builtin_amdgcn_s_sleep(1); \
    if ((++_sp & 255u) == 0u) { if (xb_ld(&(bar)[XB_TMO])) break; if (_sp > XB_SPIN_CAP) { atomicAdd(&(bar)[XB_TMO], 1u); break; } } } } while (0)

struct XcdBarrier {
    unsigned* bar; unsigned x;
    volatile LAS unsigned* st;
};

__device__ __forceinline__ XcdBarrier xcd_barrier_post(unsigned* bar, volatile LAS unsigned* st) {
    XcdBarrier b; b.bar = bar; b.x = xb_xcc_id(); b.st = st;
    if (threadIdx.x == 0) (void)xb_add(&bar[XB_XCNT(b.x)], 1u);
    return b;
}
__device__ __forceinline__ void xcd_barrier_complete(unsigned* bar, unsigned x, unsigned& nloc, unsigned& nx) {
    const unsigned G = gridDim.x * gridDim.y * gridDim.z;
    unsigned sum, cnt, mine, sp = 0u;
    for (;;) {
        sum = 0u; cnt = 0u; mine = 0u;
#pragma unroll
        for (unsigned j = 0; j < 16; ++j) { const unsigned c = xb_ld(&bar[XB_XCNT(j)]); sum += c; cnt += (c > 0u) ? 1u : 0u; mine = (j == x) ? c : mine; }
        if (sum == G) break;
        __builtin_amdgcn_s_sleep(1);
        if ((++sp & 255u) == 0u) { if (xb_ld(&bar[XB_TMO])) break; if (sp > XB_SPIN_CAP) { atomicAdd(&bar[XB_TMO], 1u); break; } }
    }
    nloc = mine > 0u ? mine : 1u; nx = cnt > 0u ? cnt : 1u;
}

__device__ __forceinline__ void xcd_barrier(const XcdBarrier& b) {
    asm volatile("s_waitcnt vmcnt(0)" ::: "memory");
    __syncthreads();
    if (threadIdx.x == 0) {
        unsigned* bar = b.bar;
        __builtin_amdgcn_s_waitcnt(0);
        unsigned nloc = b.st[0], nx = b.st[1];
        if (nloc == 0u) { xcd_barrier_complete(bar, b.x, nloc, nx); b.st[0] = nloc; b.st[1] = nx; }
        const unsigned old = xb_add(&bar[XB_XSUB(b.x)], 1u);
        const unsigned gen = old / nloc;
        if (old + 1u == (gen + 1u) * nloc) {
            __builtin_amdgcn_fence(__ATOMIC_RELEASE, "agent");
            asm volatile("s_waitcnt vmcnt(0)" ::: "memory");
            const unsigned og = xb_add(&bar[XB_TOP], 1u);
            const unsigned tg = og / nx;
            if (og + 1u == (tg + 1u) * nx) xb_add(&bar[XB_TOPGEN], 1u);
            else XB_SPIN(xb_ld(&bar[XB_TOPGEN]) == tg, bar);
            __builtin_amdgcn_fence(__ATOMIC_ACQUIRE, "agent");
            xb_add(&bar[XB_XGEN(b.x)], 1u);
            asm volatile("s_waitcnt vmcnt(0)" ::: "memory");
        } else {
            XB_SPIN(xb_ld(&bar[XB_XGEN(b.x)]) == gen, bar);
            __builtin_amdgcn_fence(__ATOMIC_ACQUIRE, "agent");
            asm volatile("s_waitcnt vmcnt(0)" ::: "memory");
        }
    }
    __syncthreads();
}


constexpr int N_PHASES = 23;
#ifndef PH_MASK
#define PH_MASK 0xffffffffu
#endif
#define PHON(k) ((PH_MASK >> (k)) & 1u)
#ifndef REPEAT_MASK
#define REPEAT_MASK 0u
#endif
#ifndef EXTRA_SYNCS
#define EXTRA_SYNCS 0
#endif
__global__ void __launch_bounds__(NTHREADS, 2) trunk_fwd(Params Pk) {
    extern __shared__ __attribute__((aligned(16))) unsigned char lds_raw[];
    LAS unsigned char* lds = (LAS unsigned char*)lds_raw;
    const int ph_lo = Pk.ph_lo, ph_hi = Pk.ph_hi;
    const int wave_s = __builtin_amdgcn_readfirstlane((int)threadIdx.x >> 6);
    volatile LAS unsigned* xb_st = (volatile LAS unsigned*)(lds + 144 * 1024);
    if (threadIdx.x < 2) xb_st[threadIdx.x] = 0u;
    __syncthreads();
    if (ph_hi - ph_lo > 1) (void)xcd_barrier_post((unsigned*)(Pk.ws + WS_BAR), xb_st);

    for (int ph = ph_lo; ph < ph_hi; ++ph) for (int rep = 0; rep < 1 + (int)((REPEAT_MASK >> ph) & 1u); ++rep) {
        if (ph == 5 || ph == 19) continue;
        if (ph != ph_lo || rep) {
            if (ph == 1 && rep == 0) cg::this_grid().sync();
            else { XcdBarrier xb; xb.bar = (unsigned*)((*(const __attribute__((address_space(4))) Params*)__builtin_amdgcn_kernarg_segment_ptr()).ws + WS_BAR); xb.x = xb_xcc_id(); xb.st = xb_st; xcd_barrier(xb); }
        }
        if (EXTRA_SYNCS && ph == 2 && rep == 0) { for (int e = 0; e < EXTRA_SYNCS; ++e) { XcdBarrier xb; xb.bar = (unsigned*)((*(const __attribute__((address_space(4))) Params*)__builtin_amdgcn_kernarg_segment_ptr()).ws + WS_BAR); xb.x = xb_xcc_id(); xb.st = xb_st; xcd_barrier(xb); } }
        const __attribute__((address_space(4))) Params* Pp = (const __attribute__((address_space(4))) Params*)__builtin_amdgcn_kernarg_segment_ptr(); asm volatile("" : "+s"(Pp));
#define P (*Pp)
        unsigned char* ws = P.ws;
        float* cosT = (float*)(ws + WS_COS); float* sinT = (float*)(ws + WS_SIN); float* LF = (float*)(ws + WS_LF); float* C2 = (float*)(ws + WS_C2); float* SS = (float*)(ws + WS_SS); float* RS = (float*)(ws + WS_RS); float* PS = (float*)(ws + WS_PS);
        bf16_t* XN = (bf16_t*)(ws + WS_XN);
        float* H = P.out;
        int lane; asm volatile("v_mbcnt_lo_u32_b32 %0, -1, 0\n\tv_mbcnt_hi_u32_b32 %0, -1, %0" : "=v"(lane));
        int wave = wave_s; asm volatile("" : "+s"(wave));
        const int tid = wave * 64 + lane;
        int bx = blockIdx.x; asm volatile("" : "+s"(bx));
        int G = gridDim.x; asm volatile("" : "+s"(G));
        const int NGW = G * NWAVES, NGT = G * NTHREADS;
        const int gw = bx * NWAVES + wave, gt = bx * NTHREADS + tid;
        if (ph == 0 && PHON(0)) {
            LAS float* scr = (LAS float*)(lds + wave * 8448);
            LAS unsigned char* gtab = lds + 69632;
            for (int E = tid; E < 4096; E += NTHREADS) {
                const int j = E >> 9, q = (E >> 6) & 7, lk = E & 63, k0 = 4 * lk + 256 * j;
                const f32x4 g4 = *(const f32x4*)(P.fox_norm + k0);
                float wa[4], wb[4];
#pragma unroll
                for (int i = 0; i < 4; ++i) { wa[i] = P.fox_wf[(k0 + i) * 16 + 2 * q] * g4[i]; wb[i] = P.fox_wf[(k0 + i) * 16 + 2 * q + 1] * g4[i]; }
                u32x4 w; w.x = pk2(wa[0], wa[1]); w.y = pk2(wa[2], wa[3]); w.z = pk2(wb[0], wb[1]); w.w = pk2(wb[2], wb[3]);
                *(LAS u32x4*)(gtab + E * 16) = w;
            }
            __syncthreads();
            int base = 0;
#pragma unroll 1
            for (int j = 0; j < 13; ++j) {
                const float* W_; const float* G_ = nullptr; int K_ = DM, N_ = DM, OFF_ = 0; size_t WT_;
                switch (j) {
                    case 0: W_ = P.fox_wq; G_ = P.fox_norm; WT_ = WS_FQKF; break;
                    case 1: W_ = P.fox_wk; G_ = P.fox_norm; WT_ = WS_FQKF; OFF_ = 2048; break;
                    case 2: W_ = P.fox_wv; G_ = P.fox_norm; WT_ = WS_FWV; break;
                    case 3: W_ = P.fox_wo; WT_ = WS_FWO; break;
                    case 4: W_ = P.mlp_up; G_ = P.mlp_norm; N_ = DFF; WT_ = WS_UP0; break;
                    case 5: W_ = P.mlp_down; K_ = DFF; WT_ = WS_DN0; break;
                    case 6: W_ = P.ret_wq; G_ = P.ret_norm; WT_ = WS_RWQKG; break;
                    case 7: W_ = P.ret_wk; G_ = P.ret_norm; WT_ = WS_RWQKG; OFF_ = 2048; break;
                    case 8: W_ = P.ret_wg; G_ = P.ret_norm; N_ = 4096; WT_ = WS_RWQKG; OFF_ = 4096; break;
                    case 9: W_ = P.ret_wv; G_ = P.ret_norm; N_ = 4096; WT_ = WS_RWV; break;
                    case 10: W_ = P.ret_wo; K_ = 4096; WT_ = WS_RWO; break;
                    case 11: W_ = P.mlp_up + (size_t)DM * DFF; G_ = P.mlp_norm + DM; N_ = DFF; WT_ = WS_UP1; break;
                    default: W_ = P.mlp_down + (size_t)DM * DFF; K_ = DFF; WT_ = WS_DN1; break;
                }
                const int ni = (K_ / 64) * (N_ / 32); int it = gw - (base % NGW); if (it < 0) it += NGW;
                transpose_job(W_, G_, K_, N_, (bf16_t*)(ws + WT_), OFF_, scr, it, ni, NGW, lane); base += ni;
            }
            for (int i = gt; i < SEQ * 128; i += NGT) { const int s = i >> 7, j = i & 127; const float inv = powf(10000.f, -(float)j / 128.f); const float ang = (float)s * inv; cosT[i] = cosf(ang); sinT[i] = sinf(ang); }
            for (int mrow = gw; mrow < MTOK; mrow += NGW) {
                const f32x4* xr = (const f32x4*)(P.x + (size_t)mrow * DM) + lane; f32x4 v[8]; float sq = 0.f;
#pragma unroll
                for (int j = 0; j < 8; ++j) { v[j] = xr[64 * j]; sq += (v[j].x * v[j].x + v[j].y * v[j].y) + (v[j].z * v[j].z + v[j].w * v[j].w); }
                sq = wave_sum(sq);
                const float rstd = 1.f / sqrtf(sq * (1.f / DM) + RMS_EPS);
                if (lane == 0) RS[mrow] = rstd;
                {
                    float ga[16];
#pragma unroll
                    for (int hq = 0; hq < 16; ++hq) ga[hq] = 0.f;
#pragma unroll
                    for (int j = 0; j < 8; ++j)
#pragma unroll
                        for (int q = 0; q < 8; ++q) {
                            const u32x4 w = *(LAS const u32x4*)(gtab + ((j * 8 + q) * 64 + lane) * 16);
                            ga[2 * q] += v[j].x * __builtin_bit_cast(float, w.x << 16) + v[j].y * __builtin_bit_cast(float, w.x & 0xffff0000u)
                                       + v[j].z * __builtin_bit_cast(float, w.y << 16) + v[j].w * __builtin_bit_cast(float, w.y & 0xffff0000u);
                            ga[2 * q + 1] += v[j].x * __builtin_bit_cast(float, w.z << 16) + v[j].y * __builtin_bit_cast(float, w.z & 0xffff0000u)
                                           + v[j].z * __builtin_bit_cast(float, w.w << 16) + v[j].w * __builtin_bit_cast(float, w.w & 0xffff0000u);
                            if ((q & 3) == 3) __builtin_amdgcn_sched_barrier(0);
                        }
                    float zsel = 0.f;
#pragma unroll
                    for (int hq = 0; hq < 16; ++hq) { const float t_ = wave_sum(ga[hq]); zsel = (lane == hq) ? t_ : zsel; }
                    if (lane < 16) { const float z = zsel * rstd + P.fox_bf[lane]; LF[(size_t)mrow * 16 + lane] = fminf(z, 0.f) - log1pf(expf(-fabsf(z))); }
                }
                u32x2* o8 = (u32x2*)(XN + (size_t)mrow * DM) + lane;
#pragma unroll
                for (int j = 0; j < 8; ++j) { u32x2 pk; pk.x = cvt_pk_bf16(v[j].x, v[j].y); pk.y = cvt_pk_bf16(v[j].z, v[j].w); o8[64 * j] = pk; }
            }
        }
        else if (ph == 1 && PHON(1)) {
            const SchedF1 S{(const char*)XN, (const char*)(ws + WS_FQKF), (const char*)(ws + WS_FWV), G, bx};
            const EpiF1 E{(bf16_t*)(ws + WS_FQ), (bf16_t*)(ws + WS_FK), (bf16_t*)(ws + WS_FVT), LF, P.fox_bf, 0.08838834764831845f * LOG2E, RS};
            pg::gemm_phase(lds, tid, pg::Cfg{DM, DM, 32, 32}, S, E);
        }
        else if (ph == 2 && PHON(2)) {
            LAS float* wtot = (LAS float*)lds;
            for (int bh = bx; bh < 64; bh += G) {
                const int b = bh >> 4, h = bh & 15;
                float v[8]; float run = 0.f;
#pragma unroll
                for (int i = 0; i < 8; ++i) { run += LF[(size_t)(b * SEQ + tid * 8 + i) * 16 + h]; v[i] = run; }
                float incl = run;
#pragma unroll
                for (int o = 1; o < 64; o <<= 1) { const float t = __shfl_up(incl, o); if (lane >= o) incl += t; }
                if (lane == 63) wtot[wave] = incl;
                __syncthreads();
                float off = incl - run;
                for (int w = 0; w < wave; ++w) off += wtot[w];
#pragma unroll
                for (int i = 0; i < 8; ++i) C2[(size_t)bh * SEQ + tid * 8 + i] = (v[i] + off) * LOG2E;
                __syncthreads();
            }
        }
        else if (ph == 3 && PHON(3)) {
            const int vcu = (G % 8 == 0) ? (bx % 8) * (G / 8) + bx / 8 : bx;
            for (int p = vcu; p < 512; p += G) {
                const int bh = p >> 3, s = p & 7;
                attn_unit(lds, tid, bh, 15 - s, (const bf16_t*)(ws + WS_FQ), (const bf16_t*)(ws + WS_FK), (const bf16_t*)(ws + WS_FVT), C2, (bf16_t*)(ws + WS_FO));
                attn_unit(lds, tid, bh, s, (const bf16_t*)(ws + WS_FQ), (const bf16_t*)(ws + WS_FK), (const bf16_t*)(ws + WS_FVT), C2, (bf16_t*)(ws + WS_FO));
            }
        }
        else if (ph == 4 && PHON(4)) {
            const SchedPlain S{(const char*)(ws + WS_FO), (const char*)(ws + WS_FWO), 64, 8, (size_t)256 * DM * 2, (size_t)256 * DM * 2, G, bx};
            pg::gemm_phase(lds, tid, pg::Cfg{DM, DM, 32, 32}, S, EpiResT<true>{P.x, XN, PS, 1});
        }
        else if ((ph == 5 || ph == 8 || ph == 19) && PHON(5)) {
            for (int mrow = gt; mrow < MTOK; mrow += NGT) {
                const f32x4* pp = (const f32x4*)(PS + (size_t)mrow * 32); float tot = 0.f;
#pragma unroll
                for (int j = 0; j < 8; ++j) { const f32x4 a = pp[j]; tot += (a.x + a.y) + (a.z + a.w); }
                RS[mrow] = 1.f / sqrtf(tot * (1.f / DM) + RMS_EPS);
            }
        }
        else if ((ph == 6 || ph == 20) && PHON(6)) {
            const SchedPlain S{(const char*)XN, (const char*)(ws + (ph == 6 ? WS_UP0 : WS_UP1)), 64, 32, (size_t)256 * DM * 2, (size_t)256 * DM * 2, G, bx};
            pg::gemm_phase(lds, tid, pg::Cfg{DM, DM, 32, 32}, S, EpiUp{(bf16_t*)(ws + WS_U), PS});
        }
        else if ((ph == 7 || ph == 21) && PHON(7)) {
            const SchedPlain S{(const char*)(ws + WS_U), (const char*)(ws + (ph == 7 ? WS_DN0 : WS_DN1)), 64, 8, (size_t)256 * DFF * 2, (size_t)256 * DFF * 2, G, bx};
            pg::gemm_phase(lds, tid, pg::Cfg{DFF, DFF, 128, 128}, S, EpiRes{nullptr, XN, PS, ph == 7 ? 1 : 0});
        }
        else if (ph >= 9 && ph <= 16) {
            const int hb = (ph - 9) >> 2, sub = (ph - 9) & 3;
            bf16_t* QR = (bf16_t*)(ws + WS_QR); bf16_t* KR = (bf16_t*)(ws + WS_KR); bf16_t* KT = (bf16_t*)(ws + WS_KT); bf16_t* VDT = (bf16_t*)(ws + WS_VDT); bf16_t* ST = (bf16_t*)(ws + WS_ST); bf16_t* Gt = (bf16_t*)(ws + WS_G);
            if (sub == 0 && PHON(9)) {
                const SchedR1 S{(const char*)(XN + (size_t)hb * 8192 * DM), (const char*)(ws + WS_RWQKG), (const char*)(ws + WS_RWV), G, bx};
                const EpiR1 E{QR, KR, KT, Gt, VDT, cosT, sinT, hb, RS};
                pg::gemm_phase(lds, tid, pg::Cfg{DM, DM, 32, 32}, S, E);
            } else if (sub == 1 && PHON(10)) {
                const SchedR2 S{(const char*)QR, (const char*)KR, (const char*)KT, (const char*)VDT, G, bx};
                pg::gemm_phase(lds, tid, pg::Cfg{256, 256, 4, 4}, S, EpiR2{KR, ST});
            } else if (sub == 2 && PHON(11)) {
                for (int id = gt; id < 16 * 16384; id += NGT) {
                    const int bhl = id >> 14, rem = id & 16383;
                    const float gC = fexp2(256.f * ret_lg2(bhl & 7));
                    bf16_t* p0 = ST + (size_t)bhl * 17 * 131072 + (size_t)rem * 8;
                    { unsigned zv = 0u; asm volatile("" : "+v"(zv)); *(u32x4*)p0 = (u32x4){zv, zv, zv, zv}; }
                    u32x4 uv[15];
#pragma unroll
                    for (int n = 0; n < 15; ++n) uv[n] = *(const u32x4*)(p0 + (size_t)(n + 1) * 131072);
                    float s[8];
#pragma unroll
                    for (int e = 0; e < 8; ++e) s[e] = 0.f;
#pragma unroll
                    for (int n = 0; n < 15; ++n) {
                        const unsigned w[4] = {uv[n].x, uv[n].y, uv[n].z, uv[n].w};
#pragma unroll
                        for (int q = 0; q < 4; ++q) { s[2 * q] = s[2 * q] * gC + __builtin_bit_cast(float, w[q] << 16); s[2 * q + 1] = s[2 * q + 1] * gC + __builtin_bit_cast(float, w[q] & 0xffff0000u); }
                        u32x4 ov; ov.x = cvt_pk_bf16(s[0], s[1]); ov.y = cvt_pk_bf16(s[2], s[3]); ov.z = cvt_pk_bf16(s[4], s[5]); ov.w = cvt_pk_bf16(s[6], s[7]);
                        *(u32x4*)(p0 + (size_t)(n + 1) * 131072) = ov;
                    }
                }
            } else if (sub == 3 && PHON(12)) {
                const SchedR4 S{(const char*)KR, (const char*)QR, (const char*)VDT, (const char*)ST, G, bx};
                pg::gemm_phase(lds, tid, pg::Cfg{256, 256, 8, 4}, S, EpiR4{Gt, SS, P.ret_gn, hb});
            }
        }
        else if (ph == 17 && PHON(17)) {
            float* RAT = (float*)(ws + WS_RAT);
            for (int mrow = gt; mrow < MTOK; mrow += NGT) {
                float rs[8];
#pragma unroll
                for (int h = 0; h < 8; ++h) { const float* sp = SS + ((size_t)mrow * 8 + h) * 8; const f32x4 a = *(const f32x4*)sp, b = *(const f32x4*)(sp + 4);
                    rs[h] = 1.f / sqrtf((((a.x + a.y) + (a.z + a.w)) + ((b.x + b.y) + (b.z + b.w))) * (1.f / 512.f) + RMS_EPS); }
                f32x4 o0, o1;
                o0.x = rs[0] / rs[1]; o0.y = rs[1] / rs[2]; o0.z = rs[2] / rs[3]; o0.w = rs[3] / rs[4];
                o1.x = rs[4] / rs[5]; o1.y = rs[5] / rs[6]; o1.z = rs[6] / rs[7]; o1.w = rs[7];
                *(f32x4*)(RAT + (size_t)mrow * 8) = o0; *(f32x4*)(RAT + (size_t)mrow * 8 + 4) = o1;
            }
        }
        else if (ph == 18 && PHON(18)) {
            const SchedPlain S{(const char*)(ws + WS_G), (const char*)(ws + WS_RWO), 64, 8, (size_t)256 * 4096 * 2, (size_t)256 * 4096 * 2, G, bx};
            EpiResHook E; E.basef = nullptr; E.HB = XN; E.PS = PS; E.ps_on = 1; E.RAT = (const float*)(ws + WS_RAT);
            pg::gemm_phase(lds, tid, pg::Cfg{4096, 4096, 64, 64}, S, E);
        }
        else if (ph == 22 && PHON(22)) {
            for (int mrow = gw; mrow < MTOK; mrow += NGW) {
                const u32x2* hr = (const u32x2*)(XN + (size_t)mrow * DM) + lane; f32x4 v[8]; float s = 0.f;
#pragma unroll
                for (int j = 0; j < 8; ++j) { const u32x2 hv = hr[64 * j];
                    v[j].x = __builtin_bit_cast(float, hv.x << 16); v[j].y = __builtin_bit_cast(float, hv.x & 0xffff0000u); v[j].z = __builtin_bit_cast(float, hv.y << 16); v[j].w = __builtin_bit_cast(float, hv.y & 0xffff0000u);
                    s += (v[j].x * v[j].x + v[j].y * v[j].y) + (v[j].z * v[j].z + v[j].w * v[j].w); }
                const float rstd = 1.f / sqrtf(wave_sum(s) * (1.f / DM) + RMS_EPS);
                f32x4* xr = (f32x4*)(H + (size_t)mrow * DM) + lane;
#pragma unroll
                for (int j = 0; j < 8; ++j) { const f32x4 gg = ((const f32x4*)P.final_norm)[lane + 64 * j]; xr[64 * j] = v[j] * rstd * gg; }
            }
        }
    }
}

extern "C" void kernel_launch(void* const* d_in, const int* in_sizes, int n_in, void* d_out, int out_size, void* d_ws, size_t ws_size, hipStream_t stream) {
    static int grid = 0;
    if (grid == 0) {
        if (n_in != 19 || out_size != MTOK * DM || ws_size < WS_END) { fprintf(stderr, "kernel_launch: unexpected sizes (n_in %d out %d ws %zu)\n", n_in, out_size, ws_size); grid = -1; return; }
        int dev = 0, cus = 0, per_cu = 0;
        hipGetDevice(&dev); hipDeviceGetAttribute(&cus, hipDeviceAttributeMultiprocessorCount, dev);
        if (hipFuncSetAttribute((const void*)trunk_fwd, hipFuncAttributeMaxDynamicSharedMemorySize, LDS_BYTES) != hipSuccess) { fprintf(stderr, "kernel_launch: hipFuncSetAttribute failed\n"); grid = -1; return; }
        if (hipOccupancyMaxActiveBlocksPerMultiprocessor(&per_cu, (const void*)trunk_fwd, NTHREADS, LDS_BYTES) != hipSuccess || per_cu < 1) per_cu = 1;
        (void)hipGetLastError();
        grid = cus * per_cu;
        if (grid <= 0) grid = 256;
    }
    if (grid < 0) return;
    Params p{};
    const float** pf = (const float**)&p;
    for (int i = 0; i < 19; ++i) pf[i] = (const float*)d_in[i];
    p.out = (float*)d_out; p.ws = (unsigned char*)d_ws;
#if MK_PER_PHASE
    for (int ph = 0; ph < N_PHASES; ++ph) {
        p.ph_lo = ph; p.ph_hi = ph + 1;
        hipLaunchKernelGGL(trunk_fwd, dim3(grid), dim3(NTHREADS), LDS_BYTES, stream, p);
    }
#else
    p.ph_lo = 0; p.ph_hi = N_PHASES;
    if (hipMemsetAsync((char*)d_ws + WS_BAR, 0, 16384, stream) != hipSuccess) { fprintf(stderr, "kernel_launch: hipMemsetAsync failed\n"); return; }
    void* args[] = {&p};
    hipError_t e = hipLaunchCooperativeKernel((const void*)trunk_fwd, dim3(grid), dim3(NTHREADS), args, LDS_BYTES, stream);
    if (e != hipSuccess) fprintf(stderr, "cooperative launch failed: %s (grid %d)\n", hipGetErrorString(e), grid);
#endif
}
```
